# Optimizing an MI355X kernel written in HIP

```python
import math
import jax, jax.numpy as jnp
from jax import lax
import numpy as np

D_MODEL = 1024
BATCH = 16
SEQ = 2048
DEPTH = 2

D_MIX = D_MODEL
HGRN_HEADS = 4
HGRN_HEAD_DIM = 128
D_HGRN = HGRN_HEADS * HGRN_HEAD_DIM
HGRN_CHUNK = 64
TMLP_GROUPS = 4
TMLP_GROUP_DIM = 128
D_TMLP = TMLP_GROUPS * TMLP_GROUP_DIM
TMLP_CHUNK = 128
D_IN = 4 * D_HGRN + 2 * D_TMLP
N_EXPERT_GROUPS = 4
EXPERTS_PER_GROUP = 8
N_EXPERTS = N_EXPERT_GROUPS * EXPERTS_PER_GROUP
TOP_K_IN_GROUP = 2
D_EXPERT = 256
RMS_EPS = 1e-6
LN_EPS = 1e-5
F_FLOOR = 1e-30

kernel_name = "hybrid_hgrn2_tokenmlp_hmoe"


def rmsnorm(x, gain):
    x32 = x.astype(jnp.float32)
    y = x32 * lax.rsqrt(jnp.mean(x32 * x32, axis=-1, keepdims=True) + RMS_EPS)
    return y.astype(x.dtype) * gain


def hgrn2_mixer(q_raw, f_raw, i_raw, g_raw, lower_bound, g_norm):
    B, T, _ = q_raw.shape
    H, K, C = HGRN_HEADS, HGRN_HEAD_DIM, HGRN_CHUNK
    nC = T // C
    q = jax.nn.silu(q_raw.astype(jnp.float32))
    lb = lower_bound.astype(jnp.float32)
    f = lb + (1.0 - lb) * jax.nn.sigmoid(f_raw.astype(jnp.float32))
    log_f = jnp.log(jnp.maximum(f, F_FLOOR))
    k = 1.0 - f
    v = i_raw.astype(jnp.float32)

    def to_chunks(a):
        return a.reshape(B, nC, C, H, K).transpose(1, 0, 3, 2, 4)

    mask = jnp.tril(jnp.ones((C, C), dtype=bool))[:, :, None]

    def step(S, inp):
        qc, kc, vc, lfc = inp
        b = jnp.cumsum(lfc, axis=2)
        inter = jnp.einsum('bhtk,bhkv->bhtv', qc * jnp.exp(b), S)
        diff = b[:, :, :, None, :] - b[:, :, None, :, :]
        decay = jnp.where(mask, jnp.exp(jnp.where(mask, diff, 0.0)), 0.0)
        attn = jnp.einsum('bhtk,bhsk,bhtsk->bhts', qc, kc, decay)
        o = inter + jnp.einsum('bhts,bhsv->bhtv', attn, vc)
        b_end = b[:, :, -1, :]
        S = jnp.exp(b_end)[..., None] * S + jnp.einsum(
            'bhsk,bhsv->bhkv', kc * jnp.exp(b_end[:, :, None, :] - b), vc)
        return S, o

    S0 = jnp.zeros((B, H, K, K), jnp.float32)
    _, o = lax.scan(step, S0, (to_chunks(q), to_chunks(k), to_chunks(v), to_chunks(log_f)))
    o = o.transpose(1, 0, 3, 2, 4).reshape(B, T, H, K)
    o = rmsnorm(o, g_norm.astype(jnp.float32))
    g = jax.nn.silu(g_raw.astype(jnp.float32)).reshape(B, T, H, K)
    return (o * g).reshape(B, T, D_HGRN).astype(q_raw.dtype)


def token_mlp_mixer(u_raw, v_raw, ln_g, ln_b, w_s, b_s):
    B, T, _ = u_raw.shape
    G, Cg, P = TMLP_GROUPS, TMLP_GROUP_DIM, TMLP_CHUNK
    nC = T // P
    u = jax.nn.gelu(u_raw, approximate=False).reshape(B, nC, P, G, Cg)
    v = jax.nn.gelu(v_raw, approximate=False).reshape(B, nC, P, G, Cg)
    v32 = v.astype(jnp.float32)
    mu = jnp.mean(v32, axis=-1, keepdims=True)
    var = jnp.mean(jnp.square(v32 - mu), axis=-1, keepdims=True)
    vn = ((v32 - mu) * lax.rsqrt(var + LN_EPS)).astype(v.dtype)
    vn = vn * ln_g.reshape(G, Cg) + ln_b.reshape(G, Cg)
    w = jnp.where(jnp.tril(jnp.ones((P, P), dtype=bool))[None], w_s, 0.0)
    mixed = jnp.einsum('gts,bnsgc->bntgc', w, vn) + b_s.T[None, None, :, :, None]
    return (u * mixed).reshape(B, T, D_TMLP)


def hierarchical_moe(h, w_router_group, w_router_expert, w_gate, w_up, w_down):
    B, T, D = h.shape
    hf = h.reshape(B * T, D)
    p_group = jax.nn.softmax(jnp.einsum('nd,dg->ng', hf, w_router_group).astype(jnp.float32), axis=-1)
    g_idx = jnp.argmax(p_group, axis=-1)
    p_sel = jnp.max(p_group, axis=-1)
    e_logits = jnp.einsum('nd,de->ne', hf, w_router_expert).astype(jnp.float32)
    e_logits = e_logits.reshape(-1, N_EXPERT_GROUPS, EXPERTS_PER_GROUP)
    in_group = jnp.take_along_axis(e_logits, g_idx[:, None, None], axis=1)[:, 0, :]
    top_vals, top_idx = lax.top_k(in_group, TOP_K_IN_GROUP)
    w_top = p_sel[:, None] * jax.nn.softmax(top_vals, axis=-1)
    e_idx = g_idx[:, None] * EXPERTS_PER_GROUP + top_idx
    combine = jnp.sum(jax.nn.one_hot(e_idx, N_EXPERTS, dtype=jnp.float32) * w_top[..., None], axis=1)
    combine = combine.astype(h.dtype).reshape(B, T, N_EXPERTS)

    def per_sequence(args):
        hb, cb = args
        hid = jax.nn.silu(jnp.einsum('td,edf->tef', hb, w_gate)) * jnp.einsum('td,edf->tef', hb, w_up)
        return jnp.einsum('tef,efd->td', hid * cb[..., None], w_down)

    return lax.map(per_sequence, (h, combine))


def setup_inputs(seed: int = 0) -> dict:
    key = jax.random.key(seed)
    ks = jax.random.split(key, 20)
    f32 = jnp.float32
    nrm = lambda k, shape, scale: jax.random.normal(k, shape, f32) * scale
    gain = lambda k, shape: 1.0 + 0.05 * jax.random.normal(k, shape, f32)
    P = TMLP_CHUNK
    return {
        "x": jax.random.normal(ks[0], (BATCH, SEQ, D_MODEL), f32),
        "lb_logits": nrm(ks[1], (DEPTH, D_HGRN), 0.5),
        "norm_mix": gain(ks[2], (DEPTH, D_MODEL)),
        "w_in": nrm(ks[3], (DEPTH, D_MODEL, D_IN), D_MODEL ** -0.5),
        "hgrn_norm": gain(ks[4], (DEPTH, HGRN_HEAD_DIM)),
        "tmlp_ln_g": gain(ks[5], (DEPTH, D_TMLP)),
        "tmlp_ln_b": nrm(ks[6], (DEPTH, D_TMLP), 0.02),
        "w_spatial": nrm(ks[7], (DEPTH, TMLP_GROUPS, P, P), 0.5 * P ** -0.5),
        "b_spatial": 1.0 + nrm(ks[8], (DEPTH, TMLP_GROUPS, P), 0.05),
        "w_out": nrm(ks[9], (DEPTH, D_MIX, D_MODEL), D_MIX ** -0.5),
        "norm_ffn": gain(ks[10], (DEPTH, D_MODEL)),
        "w_router_group": nrm(ks[11], (DEPTH, D_MODEL, N_EXPERT_GROUPS), D_MODEL ** -0.5),
        "w_router_expert": nrm(ks[12], (DEPTH, D_MODEL, N_EXPERTS), D_MODEL ** -0.5),
        "w_gate": nrm(ks[13], (DEPTH, N_EXPERTS, D_MODEL, D_EXPERT), D_MODEL ** -0.5),
        "w_up": nrm(ks[14], (DEPTH, N_EXPERTS, D_MODEL, D_EXPERT), D_MODEL ** -0.5),
        "w_down": nrm(ks[15], (DEPTH, N_EXPERTS, D_EXPERT, D_MODEL), D_EXPERT ** -0.5),
        "norm_final": gain(ks[16], (D_MODEL,)),
    }


def reference(x, lb_logits, norm_mix, w_in, hgrn_norm, tmlp_ln_g, tmlp_ln_b, w_spatial, b_spatial,
              w_out, norm_ffn, w_router_group, w_router_expert, w_gate, w_up, w_down, norm_final):
    p = jax.nn.softmax(lb_logits.astype(jnp.float32), axis=0)
    lower_bounds = jnp.cumsum(p, axis=0) - p[0:1]
    splits = [D_HGRN, 2 * D_HGRN, 3 * D_HGRN, 4 * D_HGRN, 4 * D_HGRN + D_TMLP]
    for layer in range(DEPTH):
        h = rmsnorm(x, norm_mix[layer])
        z = jnp.einsum('btd,de->bte', h, w_in[layer])
        q_r, f_r, i_r, g_r, u_r, v_r = jnp.split(z, splits, axis=-1)
        y_hgrn = hgrn2_mixer(q_r, f_r, i_r, g_r, lower_bounds[layer], hgrn_norm[layer])
        y_tmlp = token_mlp_mixer(u_r, v_r, tmlp_ln_g[layer], tmlp_ln_b[layer],
                                 w_spatial[layer], b_spatial[layer])
        y = jnp.concatenate([y_hgrn, y_tmlp], axis=-1)
        x = x + jnp.einsum('bte,ed->btd', y, w_out[layer])
        h = rmsnorm(x, norm_ffn[layer])
        x = x + hierarchical_moe(h, w_router_group[layer], w_router_expert[layer],
                                 w_gate[layer], w_up[layer], w_down[layer])
    return rmsnorm(x, norm_final)
```

```cpp
#include <hip/hip_runtime.h>
#include <cstdio>
#include <cstdint>

#ifndef MK_REPEAT
#define MK_REPEAT 0
#endif
#ifndef MK_MIXSEL
#define MK_MIXSEL 15
#endif
#ifndef MK_XSEAM
#define MK_XSEAM 0
#endif
#ifndef MK_PER_PHASE
#define MK_PER_PHASE 0
#endif

#define LAS __attribute__((address_space(3)))
#define GAS __attribute__((address_space(1)))
typedef unsigned short bf16_t;
typedef short bf16x8 __attribute__((ext_vector_type(8)));
typedef float f32x4 __attribute__((ext_vector_type(4)));
typedef float f32x2 __attribute__((ext_vector_type(2)));
typedef unsigned u32x4 __attribute__((ext_vector_type(4)));
typedef unsigned u32x2 __attribute__((ext_vector_type(2)));
typedef GAS unsigned gu32;

constexpr int BATCH = 16, SEQ = 2048, D = 1024, M = BATCH * SEQ, DIN = 3072;
constexpr int NEXP = 32, DEXP = 256, NLAYER = 2;
constexpr float RMS_EPS = 1e-6f, LN_EPS = 1e-5f;
#define TILE_OFF(h_, row_) (((size_t)(h_) * M + (size_t)(row_)) * 128)
constexpr int LISTCAP = 32768;

constexpr size_t MiB = 1u << 20;
constexpr size_t WS_CTL = 0, CTL_ZERO_BYTES = 1 * MiB;
constexpr size_t WS_WIN = 1 * MiB;
constexpr size_t WS_WOUT = 13 * MiB;
constexpr size_t WS_W13 = 17 * MiB;
constexpr size_t WS_WD = 81 * MiB;
constexpr size_t WS_WR = 113 * MiB;
constexpr size_t WS_WSP = 113 * MiB + 512 * 1024;
constexpr size_t WS_RSTD1 = 114 * MiB;
constexpr size_t WS_LIST = 115 * MiB;
constexpr size_t WS_RS = 123 * MiB;
constexpr size_t WS_WT = 131 * MiB;
constexpr size_t WS_XSA = 140 * MiB;
constexpr size_t WS_XSB = 204 * MiB;
constexpr size_t WS_Z = 268 * MiB;
constexpr size_t WS_QT = WS_Z, WS_KT = WS_Z + 32 * MiB, WS_VH = WS_Z + 64 * MiB, WS_GH = WS_Z + 96 * MiB;
constexpr size_t WS_EB = WS_Z + 128 * MiB, WS_ER = WS_Z + 129 * MiB, WS_EK = WS_Z + 130 * MiB;
constexpr size_t WS_OL = WS_Z + 136 * MiB;
constexpr size_t WS_SL = WS_Z + 168 * MiB;
constexpr size_t WS_DL = WS_Z + 184 * MiB;
constexpr size_t OUT_Y = 0, OUT_U = 64 * MiB, OUT_V = 96 * MiB;
constexpr size_t WS_EO = WS_Z;
constexpr size_t OUT_HID = 0;
constexpr size_t WS_CLIST = 135 * MiB;
constexpr size_t WS_SSQ = 137 * MiB;
constexpr int CLCAP = 2048, ZROW = 320 * 256;
constexpr int CW_CNT2 = 65536;
constexpr size_t WS_TOKC = 123 * MiB + 4 * MiB;
constexpr size_t WS_END = 460 * MiB;
constexpr int CW_TMO = 0, CW_CODE = 1, CW_BAR = 4096, CW_CNT = 16384;

constexpr int RING_BYTES = 131072;
constexpr int TAB_OFF = 131072;
constexpr int MOE_OFF = TAB_OFF + 4096;
constexpr int LDS_BYTES = 155648;
constexpr int MISC_OFF = LDS_BYTES - 256;

__device__ __forceinline__ unsigned cvt_pk_bf16(float lo, float hi) { unsigned r; asm volatile("v_cvt_pk_bf16_f32 %0, %1, %2" : "=v"(r) : "v"(lo), "v"(hi)); return r; }
__device__ __forceinline__ int otid() { int t = (int)threadIdx.x; asm volatile("" : "+v"(t)); return t; }
__device__ __forceinline__ float bf_lo(unsigned u) { return __uint_as_float(u << 16); }
__device__ __forceinline__ float bf_hi(unsigned u) { return __uint_as_float(u & 0xffff0000u); }
__device__ __forceinline__ float bf1(bf16_t u) { return __uint_as_float((unsigned)u << 16); }
__device__ __forceinline__ float fexp2(float x) { return __builtin_amdgcn_exp2f(x); }
__device__ __forceinline__ float fexp(float x) { return __builtin_amdgcn_exp2f(x * 1.4426950408889634f); }
__device__ __forceinline__ float frcp(float x) { return __builtin_amdgcn_rcpf(x); }
__device__ __forceinline__ float silu_f(float x) { return x * frcp(1.0f + fexp(-x)); }
__device__ __forceinline__ float wave_sum(float v) {
#pragma unroll
    for (int o = 1; o < 64; o <<= 1) v += __shfl_xor(v, o);
    return v;
}
__device__ __forceinline__ float gelu_f(float v) {
    const float av = __builtin_fabsf(v), d = av * 0.2316418882f + 1.0f, t = frcp(d);
    float q = t * 0.5307027145f + (-0.7265760135f); q = q * t + 0.7107068705f; q = q * t + (-0.142248368f); q = q * t + 0.127414796f; q = q * t;
    const float e = fexp2((v * v) * (-0.72134752044f));
    const float m = v * (q * e), r = v - m;
    return v < 0.f ? m : r;
}

#define XB_TMO      128
#define XB_XCNT(j)  (256  + 64 * (j))
#define XB_XSUB(j)  (1280 + 64 * (j))
#define XB_XGEN(j)  (2304 + 64 * (j))
#define XB_TOP      3328
#define XB_TOPGEN   3392
#define XCD_BAR_WORDS 3456
#define XB_SPIN_CAP (1u << 18)
__device__ __forceinline__ unsigned xb_ld(unsigned* p)              { return __hip_atomic_load(p, __ATOMIC_RELAXED, __HIP_MEMORY_SCOPE_AGENT); }
__device__ __forceinline__ unsigned xb_add(unsigned* p, unsigned v) { return __hip_atomic_fetch_add(p, v, __ATOMIC_RELAXED, __HIP_MEMORY_SCOPE_AGENT); }
__device__ __forceinline__ unsigned xb_xcc_id() { return (unsigned)__builtin_amdgcn_s_getreg((3 << 11) | 20) & 0xFu; }
#define XB_SPIN(cond, bar) do { unsigned _sp = 0; while (cond) { __builtin_amdgcn_s_sleep(1); \
    if ((++_sp & 255u) == 0u) { if (xb_ld(&(bar)[XB_TMO])) break; if (_sp > XB_SPIN_CAP) { atomicAdd(&(bar)[XB_TMO], 1u); break; } } } } while (0)
struct XcdBarrier { unsigned* bar; unsigned x; volatile LAS unsigned* st; };
__device__ __forceinline__ XcdBarrier xcd_barrier_post(unsigned* bar, volatile LAS unsigned* st) {
    XcdBarrier b; b.bar = bar; b.x = xb_xcc_id(); b.st = st;
    if (threadIdx.x == 0) (void)xb_add(&bar[XB_XCNT(b.x)], 1u);
    return b;
}
__device__ __forceinline__ void xcd_barrier_complete(unsigned* bar, unsigned x, unsigned& nloc, unsigned& nx) {
    const unsigned G = gridDim.x * gridDim.y * gridDim.z;
    unsigned sum, cnt, mine, sp = 0u;
    for (;;) {
        sum = 0u; cnt = 0u; mine = 0u;
#pragma unroll
        for (unsigned j = 0; j < 16; ++j) { const unsigned c = xb_ld(&bar[XB_XCNT(j)]); sum += c; cnt += (c > 0u) ? 1u : 0u; mine = (j == x) ? c : mine; }
        if (sum == G) break;
        __builtin_amdgcn_s_sleep(1);
        if ((++sp & 255u) == 0u) { if (xb_ld(&bar[XB_TMO])) break; if (sp > XB_SPIN_CAP) { atomicAdd(&bar[XB_TMO], 1u); break; } }
    }
    nloc = mine > 0u ? mine : 1u; nx = cnt > 0u ? cnt : 1u;
}
__device__ __forceinline__ void xcd_barrier(const XcdBarrier& b) {
    asm volatile("s_waitcnt vmcnt(0)" ::: "memory");
    __syncthreads();
    if (threadIdx.x == 0) {
        unsigned* bar = b.bar;
        __builtin_amdgcn_s_waitcnt(0);
        unsigned nloc = b.st[0], nx = b.st[1];
        if (nloc == 0u) { xcd_barrier_complete(bar, b.x, nloc, nx); b.st[0] = nloc; b.st[1] = nx; }
        const unsigned old = xb_add(&bar[XB_XSUB(b.x)], 1u);
        const unsigned gen = old / nloc;
        if (old + 1u == (gen + 1u) * nloc) {
            __builtin_amdgcn_fence(__ATOMIC_RELEASE, "agent");
            asm volatile("s_waitcnt vmcnt(0)" ::: "memory");
            const unsigned og = xb_add(&bar[XB_TOP], 1u);
            const unsigned tg = og / nx;
            if (og + 1u == (tg + 1u) * nx) xb_add(&bar[XB_TOPGEN], 1u);
            else XB_SPIN(xb_ld(&bar[XB_TOPGEN]) == tg, bar);
            __builtin_amdgcn_fence(__ATOMIC_ACQUIRE, "agent");
            xb_add(&bar[XB_XGEN(b.x)], 1u);
            asm volatile("s_waitcnt vmcnt(0)" ::: "memory");
        } else {
            XB_SPIN(xb_ld(&bar[XB_XGEN(b.x)]) == gen, bar);
            __builtin_amdgcn_fence(__ATOMIC_ACQUIRE, "agent");
            asm volatile("s_waitcnt vmcnt(0)" ::: "memory");
        }
    }
    __syncthreads();
}

namespace pg8 {
constexpr int BM = 256, BK = 64, HALF = 128, HTB = HALF * BK * 2, NXCD = 8, WGM = 8;
__host__ __device__ __forceinline__ int lds_byte(int r, int c) { const int st = (r >> 4) * 2 + (c >> 5), rr = r & 15, cc = c & 31, ob = rr * 64 + cc * 2; return st * 1024 + (ob ^ (((ob >> 9) & 1) << 5)); }
__host__ __device__ __forceinline__ void stage_rc(int b, int& R, int& C) { const int st = b / 1024, sb = b % 1024, swz = sb ^ (((sb >> 9) & 1) << 5); R = (st >> 1) * 16 + swz / 64; C = (st & 1) * 32 + (swz % 64) / 2; }
__host__ __device__ __forceinline__ int perm32(int rho) { const int n = rho >> 4, i = rho & 15; return 8 * (i >> 2) + 4 * n + (i & 3); }

struct Unit { const char* A; const char* B; int pm, pn, nvalid, lbase, slot, fin; };

struct DenseOrder {
    const char* A; const char* Bt; int nM, nN, nwg, G, c; size_t tstep;
    __device__ void init(const void* A_, const void* Bt_, int Mr, int N, int K, int G_, int c_) { A = (const char*)A_; Bt = (const char*)Bt_; nM = Mr / BM; nN = N / BM; nwg = nM * nN; G = G_; c = c_; tstep = (size_t)BM * K * 2; }
    __device__ bool next(int i, Unit& u) const {
        const long L = (long)i * G + c; if (L >= nwg) return false;
        int wgid = (int)L; { const int q = nwg / NXCD, r = nwg % NXCD, xcd = wgid % NXCD, off = wgid / NXCD; wgid = (xcd < r ? xcd * (q + 1) : r * (q + 1) + (xcd - r) * q) + off; }
        const int nig = WGM * nN, gid = wgid / nig, fm = gid * WGM, gsz = (nM - fm) < WGM ? (nM - fm) : WGM;
        u.pm = fm + ((wgid % nig) % gsz); u.pn = (wgid % nig) / gsz; u.A = A + (size_t)u.pm * tstep; u.B = Bt + (size_t)u.pn * tstep; u.nvalid = 256; u.lbase = 0; u.slot = i; u.fin = 1; return true;
    }
};

struct NoHook { __device__ __forceinline__ void operator()(int) const {} };
template <class Epi, class Sched, bool GATHER, class Hook = NoHook>
__device__ __forceinline__ void gemm_phase(LAS unsigned char* lds, const int K, const Sched& S, const Epi& E, const LAS int* tab, const Hook& H = Hook()) {
    const int tid = otid(), wid = __builtin_amdgcn_readfirstlane(tid >> 6), lane = tid & 63, wr = wid >> 2, wc = wid & 3, fr = lane & 15, fq = lane >> 4;
    const int nt = K / BK;
    unsigned voffB[2];
#pragma unroll
    for (int i = 0; i < 2; ++i) { int R_, C_; stage_rc(tid * 16 + i * 8192, R_, C_); const int Rb = (R_ & ~31) + perm32(R_ & 31); voffB[i] = (unsigned)(Rb * K + C_) * 2u; }
    const size_t kstep = (size_t)(BK * 2);
    const size_t hstep = (size_t)HALF * K * 2;
    const unsigned ldsw = (unsigned)wid * 1024u;
    const int aoff = lds_byte(wr * 64 + fr, fq * 8), boff = lds_byte(wc * 32 + fr, fq * 8);
#define PG8_SA(b, h) (((b) * 2 + (h)) * HTB)
#define PG8_SB(b, h) ((4 + (b) * 2 + (h)) * HTB)
#define PG8_STAGE(bufoff, gbase, voff) do { _Pragma("unroll") for (int _i = 0; _i < 2; ++_i) \
        __builtin_amdgcn_global_load_lds((const unsigned*)((const char*)(gbase) + (voff)[_i]), (LAS unsigned*)(lds + (bufoff) + ldsw + _i * 8192), 16, 0, 0); } while (0)
#define PG8_LDA(dst, b, h) do { _Pragma("unroll") for (int m = 0; m < 4; ++m) _Pragma("unroll") for (int k = 0; k < 2; ++k) dst[m][k] = *(const LAS bf16x8*)(lds + PG8_SA(b, h) + aoff + m * 2048 + k * 1024); } while (0)
#define PG8_LDB(dst, b, h) do { _Pragma("unroll") for (int n = 0; n < 2; ++n) _Pragma("unroll") for (int k = 0; k < 2; ++k) dst[n][k] = *(const LAS bf16x8*)(lds + PG8_SB(b, h) + boff + n * 2048 + k * 1024); } while (0)
#define PG8_MMA(ai, bj, At, Bt) do { __builtin_amdgcn_s_setprio(1); _Pragma("unroll") for (int m = 0; m < 4; ++m) _Pragma("unroll") for (int n = 0; n < 2; ++n) _Pragma("unroll") for (int k = 0; k < 2; ++k) \
        acc[ai][bj][m][n] = __builtin_amdgcn_mfma_f32_16x16x32_bf16(Bt[n][k], At[m][k], acc[ai][bj][m][n], 0, 0, 0); __builtin_amdgcn_s_setprio(0); } while (0)
#define PG8_WAIT_V(n) asm volatile("s_waitcnt vmcnt(" #n ")" ::: "memory")
#define PG8_WAIT_L(n) asm volatile("s_waitcnt lgkmcnt(" #n ")" ::: "memory")
#define PG8_BAR __builtin_amdgcn_s_barrier()
#define PG8_SCHED __builtin_amdgcn_sched_barrier(0)
#define PG8_SETVA(dst, u) do { int _t = tid; if (GATHER) asm volatile("" : "+v"(_t)); _Pragma("unroll") for (int _i = 0; _i < 2; ++_i) { int _R, _C; stage_rc(_t * 16 + _i * 8192, _R, _C); \
        _Pragma("unroll") for (int _h = 0; _h < 2; ++_h) { const int _row = _R + 128 * _h; const int _gr = GATHER ? tab[(u).slot * 256 + _row] : _row; dst[_h][_i] = (unsigned)(_gr * K + _C) * 2u; } } } while (0)
    Unit cur, nxt; int ui = 0;
    if (!S.next(0, cur)) return;
    f32x4 acc[2][2][4][2];
#pragma unroll
    for (int a = 0; a < 2; ++a)
#pragma unroll
        for (int b = 0; b < 2; ++b)
#pragma unroll
            for (int m = 0; m < 4; ++m)
#pragma unroll
                for (int n = 0; n < 2; ++n) acc[a][b][m][n] = (f32x4){0.f, 0.f, 0.f, 0.f};
    bf16x8 At[4][2], B0[2][2], B1[2][2];
    unsigned vA[2][2];
    PG8_SETVA(vA, cur);
    const char* cA = cur.A; const char* cB = cur.B;
    PG8_STAGE(PG8_SB(0, 0), cB, voffB); PG8_STAGE(PG8_SB(0, 1), cB + hstep, voffB); PG8_STAGE(PG8_SA(0, 0), cA, vA[0]); PG8_STAGE(PG8_SA(0, 1), cA, vA[1]);
    if (wr == 1) PG8_BAR;
    PG8_WAIT_V(2); PG8_BAR;
    PG8_STAGE(PG8_SB(1, 0), cB + kstep, voffB); PG8_STAGE(PG8_SA(1, 0), cA + kstep, vA[0]); PG8_STAGE(PG8_SB(1, 1), cB + hstep + kstep, voffB);
    PG8_WAIT_V(6); PG8_BAR;
    for (;;) {
        const bool has_next = S.next(ui + 1, nxt);
        const char* nA = has_next ? nxt.A : cA; const char* nB = has_next ? nxt.B : cB;
#pragma unroll 1
        for (int t = 0; t < nt; t += 2) {
            const bool last = (t == nt - 2);
            const char* a1 = cA + (size_t)(t + 1) * kstep;
            const char* a2 = last ? nA : cA + (size_t)(t + 2) * kstep; const char* b2 = last ? nB : cB + (size_t)(t + 2) * kstep;
            const char* a3 = a2 + kstep; const char* b3 = b2 + kstep;
            PG8_LDB(B0, 0, 0); PG8_LDB(B1, 0, 1); PG8_SCHED; PG8_LDA(At, 0, 0); PG8_STAGE(PG8_SA(1, 1), a1, vA[1]);
            if (GATHER && last && has_next) { PG8_SETVA(vA, nxt); }
            PG8_WAIT_V(8); PG8_WAIT_L(0); PG8_BAR; PG8_MMA(0, 0, At, B0); PG8_MMA(0, 1, At, B1); PG8_BAR; PG8_SCHED;
            PG8_LDA(At, 0, 1); PG8_STAGE(PG8_SB(0, 0), b2, voffB); PG8_STAGE(PG8_SB(0, 1), b2 + hstep, voffB); PG8_STAGE(PG8_SA(0, 0), a2, vA[0]);
            PG8_WAIT_V(8); PG8_WAIT_L(0); PG8_BAR; PG8_MMA(1, 0, At, B0); PG8_MMA(1, 1, At, B1); PG8_BAR; PG8_SCHED;
            PG8_LDB(B0, 1, 0); PG8_LDB(B1, 1, 1); PG8_SCHED; PG8_LDA(At, 1, 0); PG8_STAGE(PG8_SA(0, 1), a2, vA[1]);
            PG8_WAIT_V(8); PG8_WAIT_L(0); PG8_BAR; PG8_MMA(0, 0, At, B0); PG8_MMA(0, 1, At, B1); PG8_BAR; PG8_SCHED;
            PG8_LDA(At, 1, 1); PG8_STAGE(PG8_SB(1, 0), b3, voffB); PG8_STAGE(PG8_SB(1, 1), b3 + hstep, voffB); PG8_STAGE(PG8_SA(1, 0), a3, vA[0]);
            PG8_WAIT_V(8); PG8_WAIT_L(0); PG8_BAR; PG8_MMA(1, 0, At, B0); PG8_MMA(1, 1, At, B1); PG8_BAR; PG8_SCHED;
        }
        if (cur.fin) {
        if (wr == 0) PG8_BAR;
        { int fr_ = fr, fq_ = fq; asm volatile("" : "+v"(fr_), "+v"(fq_)); E(acc, cur, wr, wc, fr_, fq_); }
        H(ui);
        }
        if (!has_next) break;
        if (cur.fin) {
#pragma unroll
        for (int a = 0; a < 2; ++a)
#pragma unroll
            for (int b = 0; b < 2; ++b)
#pragma unroll
                for (int m = 0; m < 4; ++m)
#pragma unroll
                    for (int n = 0; n < 2; ++n) acc[a][b][m][n] = (f32x4){0.f, 0.f, 0.f, 0.f};
        if (wr == 1) PG8_BAR;
        }
        cur = nxt; cA = nA; cB = nB; ++ui;
    }
    PG8_WAIT_V(0);
    PG8_BAR;
#undef PG8_SA
#undef PG8_SB
#undef PG8_STAGE
#undef PG8_LDA
#undef PG8_LDB
#undef PG8_MMA
#undef PG8_WAIT_V
#undef PG8_WAIT_L
#undef PG8_BAR
#undef PG8_SCHED
#undef PG8_SETVA
}
}

struct Args {
    const float* x; const float* lb_logits; const float* norm_mix; const float* w_in; const float* hgrn_norm; const float* ln_g; const float* ln_b;
    const float* w_sp; const float* b_sp; const float* w_out; const float* norm_ffn; const float* wr_g; const float* wr_e; const float* w_gate; const float* w_up; const float* w_down;
    const float* norm_final; float* out; unsigned char* ws; int ph_lo, ph_hi;
};

__device__ __forceinline__ float dpp_shr_add(float x, const int ctrl_sel) {
    int xi = __builtin_bit_cast(int, x), y;
    if (ctrl_sel == 1) y = __builtin_amdgcn_update_dpp(0, xi, 0x111, 0xf, 0xf, true);
    else if (ctrl_sel == 2) y = __builtin_amdgcn_update_dpp(0, xi, 0x112, 0xf, 0xf, true);
    else if (ctrl_sel == 4) y = __builtin_amdgcn_update_dpp(0, xi, 0x114, 0xf, 0xf, true);
    else y = __builtin_amdgcn_update_dpp(0, xi, 0x118, 0xf, 0xf, true);
    return x + __builtin_bit_cast(float, y);
}
struct EpiIn {
    bf16_t* QT; bf16_t* KT; bf16_t* VH; bf16_t* GH; bf16_t* UU; bf16_t* VV; float* EB; float* ER; float* EK; const LAS float* rsl; const float* lbl; int layer;
    __device__ __forceinline__ void operator()(const f32x4 (&acc)[2][2][4][2], const pg8::Unit& u, int wr, int wc, int fr, int fq) const {
        const int row0 = u.pm * 256 + wr * 64 + fr;
        const int cl = wc * 32 + 8 * fq;
        if (u.pn >= 8) {
            bf16_t* dst = (u.pn >= 10 ? VV : UU) + cl;
#pragma unroll
            for (int ai = 0; ai < 2; ++ai)
#pragma unroll
                for (int m = 0; m < 4; ++m) { const int r = row0 + ai * 128 + m * 16; const float rs = rsl[u.slot * 256 + (r - u.pm * 256)];
#pragma unroll
                    for (int bj = 0; bj < 2; ++bj) { float v[8];
#pragma unroll
                        for (int j = 0; j < 8; ++j) v[j] = gelu_f(acc[ai][bj][m][j >> 2][j & 3] * rs);
                        u32x4 w; w.x = cvt_pk_bf16(v[0], v[1]); w.y = cvt_pk_bf16(v[2], v[3]); w.z = cvt_pk_bf16(v[4], v[5]); w.w = cvt_pk_bf16(v[6], v[7]);
                        *(u32x4*)(dst + TILE_OFF((u.pn & 1) * 2 + bj, r)) = w; } }
        } else if (u.pn >= 4) {
            const int hh = u.pn - 4;
#pragma unroll
            for (int ai = 0; ai < 2; ++ai)
#pragma unroll
                for (int m = 0; m < 4; ++m) { const int r = row0 + ai * 128 + m * 16; const float rs = rsl[u.slot * 256 + (r - u.pm * 256)]; float v[8], g[8];
#pragma unroll
                    for (int j = 0; j < 8; ++j) { v[j] = acc[ai][0][m][j >> 2][j & 3] * rs; g[j] = silu_f(acc[ai][1][m][j >> 2][j & 3] * rs); }
                    u32x4 w; w.x = cvt_pk_bf16(v[0], v[1]); w.y = cvt_pk_bf16(v[2], v[3]); w.z = cvt_pk_bf16(v[4], v[5]); w.w = cvt_pk_bf16(v[6], v[7]);
                    *(u32x4*)(VH + TILE_OFF(hh, r) + cl) = w;
                    w.x = cvt_pk_bf16(g[0], g[1]); w.y = cvt_pk_bf16(g[2], g[3]); w.z = cvt_pk_bf16(g[4], g[5]); w.w = cvt_pk_bf16(g[6], g[7]);
                    *(u32x4*)(GH + TILE_OFF(hh, r) + cl) = w; }
        } else {
            const int hc = u.pn * 128 + cl;
            const int lane = (int)__builtin_amdgcn_mbcnt_hi(~0u, __builtin_amdgcn_mbcnt_lo(~0u, 0u));
            float lb[8];
#pragma unroll
            for (int j = 0; j < 8; ++j) lb[j] = layer ? frcp(1.0f + fexp(lbl[hc + j] - lbl[512 + hc + j])) : 0.f;
#pragma unroll
            for (int ai = 0; ai < 2; ++ai) {
                const int rowb = u.pm * 256 + ai * 128 + wr * 64, cg = rowb >> 6;
                float rs[4];
#pragma unroll
                for (int m = 0; m < 4; ++m) rs[m] = rsl[u.slot * 256 + (rowb - u.pm * 256) + 16 * m + fr];
                unsigned qp[4][4], kp[4][4];
#pragma unroll
                for (int jp = 0; jp < 4; ++jp) {
                    float qt[2][4], kt[2][4];
#pragma unroll
                    for (int jj = 0; jj < 2; ++jj) {
                        const int j = 2 * jp + jj; float q[4], kk[4], lf[4], T[4];
#pragma unroll
                        for (int m = 0; m < 4; ++m) { q[m] = silu_f(acc[ai][0][m][j >> 2][j & 3] * rs[m]);
                            const float sg = frcp(1.0f + fexp(-acc[ai][1][m][j >> 2][j & 3] * rs[m])), f = lb[j] + (1.0f - lb[j]) * sg;
                            kk[m] = 1.0f - f; float x = __builtin_amdgcn_logf(fmaxf(f, 1e-30f));
                            x = dpp_shr_add(x, 1); x = dpp_shr_add(x, 2); x = dpp_shr_add(x, 4); x = dpp_shr_add(x, 8);
                            lf[m] = x; T[m] = __shfl(x, lane | 15); }
                        const float r = T[0] + T[1], e = r + (T[2] + T[3]);
                        float carry = 0.f;
#pragma unroll
                        for (int m = 0; m < 4; ++m) { const float d = fminf(fmaxf(lf[m] + carry - r, -120.f), 120.f); carry += T[m]; qt[jj][m] = q[m] * fexp2(d); kt[jj][m] = kk[m] * fexp2(-d); }
                        if (fr == 0) { const size_t o = (size_t)cg * 512 + hc + j; EB[o] = fexp2(e); ER[o] = fexp2(r); EK[o] = fexp2(e - r); }
                    }
#pragma unroll
                    for (int m = 0; m < 4; ++m) { qp[m][jp] = cvt_pk_bf16(qt[0][m], qt[1][m]); kp[m][jp] = cvt_pk_bf16(kt[0][m], kt[1][m]); }
                }
#pragma unroll
                for (int m = 0; m < 4; ++m) { const size_t o = TILE_OFF(u.pn, rowb + 16 * m + fr) + cl;
                    *(u32x4*)(QT + o) = (u32x4){qp[m][0], qp[m][1], qp[m][2], qp[m][3]}; *(u32x4*)(KT + o) = (u32x4){kp[m][0], kp[m][1], kp[m][2], kp[m][3]}; }
            }
        }
    }
};
struct EpiOut {
    const bf16_t* XS; bf16_t* XD;
    __device__ __forceinline__ void operator()(const f32x4 (&acc)[2][2][4][2], const pg8::Unit& u, int wr, int wc, int fr, int fq) const {
        const int row0 = u.pm * 256 + wr * 64 + fr, col0 = u.pn * 256 + wc * 32 + 8 * fq;
#pragma unroll
        for (int ai = 0; ai < 2; ++ai)
#pragma unroll
            for (int m = 0; m < 4; ++m) {
                const size_t ro = (size_t)(row0 + ai * 128 + m * 16) * D + col0; const bf16_t* srcp = XS + ro; bf16_t* rowp = XD + ro;
#pragma unroll
                for (int bj = 0; bj < 2; ++bj) {
                    const u32x4 o = *(const u32x4*)(srcp + bj * 128);
                    const f32x4 a0 = acc[ai][bj][m][0], a1 = acc[ai][bj][m][1];
                    u32x4 w; w.x = cvt_pk_bf16(bf_lo(o.x) + a0[0], bf_hi(o.x) + a0[1]); w.y = cvt_pk_bf16(bf_lo(o.y) + a0[2], bf_hi(o.y) + a0[3]);
                    w.z = cvt_pk_bf16(bf_lo(o.z) + a1[0], bf_hi(o.z) + a1[1]); w.w = cvt_pk_bf16(bf_lo(o.w) + a1[2], bf_hi(o.w) + a1[3]);
                    *(u32x4*)(rowp + bj * 128) = w;
                }
            }
    }
};
struct EpiMoe1 {
    bf16_t* HID; const float* RS; const float* WT;
    __device__ __forceinline__ void operator()(const f32x4 (&acc)[2][2][4][2], const pg8::Unit& u, int wr, int wc, int fr, int fq) const {
        const int lr0 = wr * 64 + fr, col0 = u.pn * 128 + wc * 32 + 8 * fq;
#pragma unroll
        for (int ai = 0; ai < 2; ++ai)
#pragma unroll
            for (int m = 0; m < 4; ++m) {
                const int lr = lr0 + ai * 128 + m * 16; const bool ok = lr < u.nvalid;
                const float rs = ok ? RS[u.lbase + lr] : 0.f, wt = ok ? WT[u.lbase + lr] : 0.f;
                float v[8];
#pragma unroll
                for (int j = 0; j < 8; ++j) { const float g = acc[ai][0][m][j >> 2][j & 3] * rs, up = acc[ai][1][m][j >> 2][j & 3] * rs; v[j] = silu_f(g) * up * wt; }
                u32x4 w; w.x = cvt_pk_bf16(v[0], v[1]); w.y = cvt_pk_bf16(v[2], v[3]); w.z = cvt_pk_bf16(v[4], v[5]); w.w = cvt_pk_bf16(v[6], v[7]);
                *(u32x4*)(HID + (size_t)(u.pm * 256 + lr) * DEXP + col0) = w;
            }
    }
};
struct EpiMoe2 {
    bf16_t* EO;
    __device__ __forceinline__ void operator()(const f32x4 (&acc)[2][2][4][2], const pg8::Unit& u, int wr, int wc, int fr, int fq) const {
        const int lr0 = wr * 64 + fr, col0 = u.pn * 256 + wc * 32 + 8 * fq;
#pragma unroll
        for (int ai = 0; ai < 2; ++ai)
#pragma unroll
            for (int m = 0; m < 4; ++m) {
                const int lr = lr0 + ai * 128 + m * 16;
                if (lr < u.nvalid) {
                    bf16_t* rowp = EO + (size_t)(u.pm * 256 + lr) * D + col0;
#pragma unroll
                    for (int bj = 0; bj < 2; ++bj) {
                        const f32x4 a0 = acc[ai][bj][m][0], a1 = acc[ai][bj][m][1];
                        u32x4 w; w.x = cvt_pk_bf16(a0[0], a0[1]); w.y = cvt_pk_bf16(a0[2], a0[3]); w.z = cvt_pk_bf16(a1[0], a1[1]); w.w = cvt_pk_bf16(a1[2], a1[3]);
                        *(u32x4*)(rowp + bj * 128) = w;
                    }
                }
            }
    }
};

struct MoeOrder {
    const LAS int* pre; const LAS int* cnt; const char* Abase; const char* Bbase; int c0, ncls, nsub, G, blk; size_t a_tile_bytes, b_exp_bytes, b_sub_bytes; bool gather;
    __device__ bool next(int i, pg8::Unit& u) const {
        const int L = i * G + blk; const int t0 = pre[c0], t1 = pre[c0 + ncls];
        if ((gather && i >= 4) || L >= (t1 - t0) * nsub) return false;
        const int ti = t0 + L / nsub, sub = L % nsub;
        int c = c0, hi_ = c0 + ncls; while (hi_ - c > 1) { const int mid = (c + hi_) >> 1; if (pre[mid] <= ti) c = mid; else hi_ = mid; }
        const int j0 = (ti - pre[c]) * 256, e = c & 31;
        u.pm = ti; u.pn = sub; u.nvalid = min(256, cnt[c] - j0); u.lbase = c * LISTCAP + j0; u.slot = i; u.fin = 1;
        u.A = gather ? Abase : Abase + (size_t)ti * a_tile_bytes;
        u.B = Bbase + (size_t)e * b_exp_bytes + (size_t)sub * b_sub_bytes;
        return true;
    }
};

__device__ __forceinline__ void transpose_item(const float* W, int ldw, int k0, int n0, const float* gain, bf16_t* WT, int Kd, int drow0, LAS float* scr, int lane) {
#pragma unroll 8
    for (int i = 0; i < 32; ++i) { const int kk = 2 * i + (lane >> 5); float w = W[(size_t)(k0 + kk) * ldw + n0 + (lane & 31)]; if (gain) w *= gain[k0 + kk]; scr[kk * 33 + (lane & 31)] = w; }
    asm volatile("s_waitcnt lgkmcnt(0)" ::: "memory");
    const int c = lane & 7;
#pragma unroll
    for (int j = 0; j < 4; ++j) { const int n = (lane >> 3) + 8 * j; const LAS float* s = scr + (8 * c) * 33 + n;
        u32x4 o; o.x = cvt_pk_bf16(s[0 * 33], s[1 * 33]); o.y = cvt_pk_bf16(s[2 * 33], s[3 * 33]); o.z = cvt_pk_bf16(s[4 * 33], s[5 * 33]); o.w = cvt_pk_bf16(s[6 * 33], s[7 * 33]);
        *(u32x4*)(WT + (size_t)(drow0 + n) * Kd + k0 + 8 * c) = o; }
    asm volatile("s_waitcnt lgkmcnt(0)" ::: "memory");
}

__device__ __forceinline__ void conv_item(const float* W, int ldw, int k0, int nit, int n0, const float* gain, bf16_t* WT, int Kd, int drow0, int mode, int lane) {
    const int nl = 4 * lane;
    int dr = mode == 0 ? drow0 + nl : ((nl >> 7) * 256 + (mode - 1) * 128 + (nl & 127));
    if (mode == 3) { const int n = n0 + nl;
        dr = n; if (n < 2048) { const int seg = n >> 9, hh = (n >> 7) & 3, k = n & 127; dr = (4 * (seg >> 1) + hh) * 256 + (seg & 1) * 128 + k; } }
    const float* src = W + (size_t)k0 * ldw + n0 + nl;
    bf16_t* dst = WT + (size_t)dr * Kd + k0;
    for (int it = 0; it < nit; ++it) {
        f32x4 v[8];
#pragma unroll
        for (int j = 0; j < 8; ++j) v[j] = *(const f32x4*)(src + (size_t)(8 * it + j) * ldw);
        if (gain) {
#pragma unroll
            for (int j = 0; j < 8; ++j) v[j] = v[j] * gain[k0 + 8 * it + j];
        }
#pragma unroll
        for (int nn = 0; nn < 4; ++nn) {
            u32x4 o; o.x = cvt_pk_bf16(v[0][nn], v[1][nn]); o.y = cvt_pk_bf16(v[2][nn], v[3][nn]); o.z = cvt_pk_bf16(v[4][nn], v[5][nn]); o.w = cvt_pk_bf16(v[6][nn], v[7][nn]);
            *(u32x4*)(dst + (size_t)nn * Kd + 8 * it) = o;
        }
    }
}
__device__ __forceinline__ void conv_tile64(const float* W, int ldw, int k0, int n0, const float* gain, bf16_t* WT, int Kd, int drow0, int lane) {
    const int n4 = lane & 15, kq = lane >> 4;
    const float* src = W + (size_t)(k0 + 16 * kq) * ldw + n0 + 4 * n4;
    f32x4 v[16];
#pragma unroll
    for (int j = 0; j < 16; ++j) v[j] = *(const f32x4*)(src + (size_t)j * ldw);
    if (gain) {
        const f32x4* gp = (const f32x4*)(gain + k0 + 16 * kq);
#pragma unroll
        for (int j4 = 0; j4 < 4; ++j4) { const f32x4 g = gp[j4];
#pragma unroll
            for (int jj = 0; jj < 4; ++jj) v[4 * j4 + jj] = v[4 * j4 + jj] * g[jj]; }
    }
    bf16_t* dst = WT + (size_t)(drow0 + 4 * n4) * Kd + k0 + 16 * kq;
#pragma unroll
    for (int nn = 0; nn < 4; ++nn)
#pragma unroll
        for (int hf = 0; hf < 2; ++hf) {
            u32x4 o; o.x = cvt_pk_bf16(v[8 * hf][nn], v[8 * hf + 1][nn]); o.y = cvt_pk_bf16(v[8 * hf + 2][nn], v[8 * hf + 3][nn]); o.z = cvt_pk_bf16(v[8 * hf + 4][nn], v[8 * hf + 5][nn]); o.w = cvt_pk_bf16(v[8 * hf + 6][nn], v[8 * hf + 7][nn]);
            *(u32x4*)(dst + (size_t)nn * Kd + 8 * hf) = o;
        }
}
__device__ __forceinline__ void conv_expert_weights(const float* w_gate, const float* w_up, const float* w_down, const float* gain, bf16_t* W13l, bf16_t* WDl, int w0, int nw, int lane, int iend = 6144) {
    if (iend > 6144) iend = 6144;
    for (int it = w0; it < iend; it += nw) {
        if (it < 4096) { const int up = it >> 11, r = it & 2047, e = r >> 6, kb = (r >> 2) & 15, nb = r & 3; const int n0 = nb * 64;
            conv_tile64((up ? w_up : w_gate) + (size_t)e * D * DEXP, DEXP, kb * 64, n0, gain, W13l + (size_t)e * 512 * D, D, (n0 >> 7) * 256 + up * 128 + (n0 & 127), lane); }
        else { const int r = it - 4096, e = r >> 6, kb = (r >> 4) & 3, nb = r & 15;
            conv_tile64(w_down + (size_t)e * DEXP * D, D, kb * 64, nb * 64, nullptr, WDl + (size_t)e * D * DEXP, DEXP, nb * 64, lane); }
    }
}

constexpr int HP = 144, HP2 = 72;
constexpr int H_QT = 0, H_KT = 18432, H_V = 36864, H_ST = 55296, H_AT = 92160, H_C = 101376, H_NRM = 103424;
typedef short s16x4 __attribute__((ext_vector_type(4)));
#define LBAR() do { asm volatile("s_waitcnt lgkmcnt(0)" ::: "memory"); __builtin_amdgcn_s_barrier(); asm volatile("" ::: "memory"); } while (0)
__device__ __forceinline__ bf16x8 ldsfrag(const LAS bf16_t* base, int row, int pitch, int kofs) { return *(const LAS bf16x8*)(base + row * pitch + kofs); }
__device__ __forceinline__ bf16x8 trfrag(const LAS bf16_t* img, int pitch, int ks, int cb, int lane) {
    const int g = lane >> 4, q = (lane & 15) >> 2, p = lane & 3;
    const LAS bf16_t* a0 = img + (32 * ks + 8 * g + q) * pitch + 16 * cb + 4 * p;
    const s16x4 lo = __builtin_bit_cast(s16x4, __builtin_amdgcn_ds_read_tr16_b64_v4i16((LAS s16x4*)a0));
    const s16x4 hi = __builtin_bit_cast(s16x4, __builtin_amdgcn_ds_read_tr16_b64_v4i16((LAS s16x4*)(a0 + 4 * pitch)));
    return (bf16x8){lo[0], lo[1], lo[2], lo[3], hi[0], hi[1], hi[2], hi[3]};
}

constexpr int H_GI = 104448, H_OI = 122880;

__device__ __forceinline__ void hgrn_pass1(LAS unsigned char* lds, const bf16_t* QTg, const bf16_t* KTg, const bf16_t* VHg, const bf16_t* GHg, const float* EBg, const float* ERg, const float* EKg,
                                           bf16_t* OL, float* SL, float* DL, bf16_t* Y, const float* gnorm, int b, int h, int seg) {
    const int tid = otid(), wave = __builtin_amdgcn_readfirstlane(tid >> 6), lane = tid & 63, fr = lane & 15, fq = lane >> 4;
    LAS bf16_t* QT = (LAS bf16_t*)(lds + H_QT); LAS bf16_t* KT = (LAS bf16_t*)(lds + H_KT); LAS bf16_t* VI = (LAS bf16_t*)(lds + H_V); LAS bf16_t* ST = (LAS bf16_t*)(lds + H_ST);
    LAS bf16_t* AT = (LAS bf16_t*)(lds + H_AT); LAS float* CS = (LAS float*)(lds + H_C); LAS float* NRM = (LAS float*)(lds + H_NRM);
    LAS bf16_t* GI = (LAS bf16_t*)(lds + H_GI); LAS bf16_t* OI = (LAS bf16_t*)(lds + H_OI);
    f32x4 S[2][4];
#pragma unroll
    for (int i = 0; i < 2; ++i)
#pragma unroll
        for (int j = 0; j < 4; ++j) S[i][j] = (f32x4){0.f, 0.f, 0.f, 0.f};
    const int kq = wave >> 1, vh = wave & 1;
    const int th = wave >> 2, vq = wave & 3;
    for (int i = tid; i < 128 * HP / 2; i += 512) ((LAS unsigned*)ST)[i] = 0u;
    const size_t rowbase = (size_t)b * SEQ;
    const int hc = h * 128;
    const int prow = tid >> 4, pch = tid & 15;
    u32x4 tq[2], tk[2], tv[2], tg[2]; float cst = 0.f;
    const int csel = tid >> 7, ck = tid & 127;
    const int c0 = seg * 8, c1 = c0 + 8; float dk = 1.0f;
    const bool fin = (seg == 0);
#define HG_LOAD(c) do { const size_t o_ = TILE_OFF(h, rowbase + (size_t)(c) * 64) + (size_t)tid * 8; \
        _Pragma("unroll") for (int i_ = 0; i_ < 2; ++i_) { tq[i_] = *(const u32x4*)(QTg + o_ + 4096 * i_); tk[i_] = *(const u32x4*)(KTg + o_ + 4096 * i_); tv[i_] = *(const u32x4*)(VHg + o_ + 4096 * i_); \
            if (fin) tg[i_] = *(const u32x4*)(GHg + o_ + 4096 * i_); } \
        { const size_t cg_ = (rowbase >> 6) + (c); if (csel == 0) cst = EBg[cg_ * 512 + hc + ck]; else if (csel == 1) cst = EKg[cg_ * 512 + hc + ck]; else if (csel == 2 && (c) + 1 < c1) cst = ERg[(cg_ + 1) * 512 + hc + ck]; } } while (0)
    HG_LOAD(c0);
    for (int c = c0; c < c1; ++c) {
#pragma unroll
        for (int i = 0; i < 2; ++i) { const int o = (prow + 32 * i) * HP + pch * 8; *(LAS u32x4*)(QT + o) = tq[i]; *(LAS u32x4*)(KT + o) = tk[i]; *(LAS u32x4*)(VI + o) = tv[i]; if (fin) *(LAS u32x4*)(GI + o) = tg[i]; }
        if (tid < 384) CS[tid] = cst;
        if (c + 1 < c1) HG_LOAD(c + 1);
        const int tb = wave >> 1, wh = wave & 1, trow = tb * 16 + fr;
        LBAR();
        if (tid < 128) dk *= CS[tid];
        bf16x8 qf[4];
#pragma unroll
        for (int ks = 0; ks < 4; ++ks) qf[ks] = ldsfrag(QT, trow, HP, ks * 32 + fq * 8);
#pragma unroll
        for (int x = 0; x < 2; ++x) {
            const int sb = 2 * wh + x; f32x4 a = (f32x4){0.f, 0.f, 0.f, 0.f};
            if (sb <= tb) {
#pragma unroll
                for (int ks = 0; ks < 4; ++ks) a = __builtin_amdgcn_mfma_f32_16x16x32_bf16(ldsfrag(KT, sb * 16 + fr, HP, ks * 32 + fq * 8), qf[ks], a, 0, 0, 0);
            }
            const int s0 = sb * 16 + 4 * fq; float v[4];
#pragma unroll
            for (int i = 0; i < 4; ++i) v[i] = (sb <= tb && s0 + i <= trow) ? a[i] : 0.f;
            *(LAS u32x2*)(AT + trow * HP2 + s0) = (u32x2){cvt_pk_bf16(v[0], v[1]), cvt_pk_bf16(v[2], v[3])};
        }
        {
            bf16x8 kf[2][2];
#pragma unroll
            for (int i = 0; i < 2; ++i)
#pragma unroll
                for (int ks = 0; ks < 2; ++ks) kf[i][ks] = trfrag(KT, HP, ks, 2 * kq + i, lane);
            f32x4 eb[2], ek[2];
#pragma unroll
            for (int i = 0; i < 2; ++i) { eb[i] = *(const LAS f32x4*)(CS + (2 * kq + i) * 16 + 4 * fq); ek[i] = *(const LAS f32x4*)(CS + 128 + (2 * kq + i) * 16 + 4 * fq); }
#pragma unroll
            for (int j = 0; j < 4; ++j) {
                bf16x8 vf[2];
#pragma unroll
                for (int ks = 0; ks < 2; ++ks) vf[ks] = trfrag(VI, HP, ks, 4 * vh + j, lane);
#pragma unroll
                for (int i = 0; i < 2; ++i) { f32x4 p = (f32x4){0.f, 0.f, 0.f, 0.f};
#pragma unroll
                    for (int ks = 0; ks < 2; ++ks) p = __builtin_amdgcn_mfma_f32_16x16x32_bf16(kf[i][ks], vf[ks], p, 0, 0, 0);
                    S[i][j] = S[i][j] * eb[i] + p * ek[i]; }
            }
        }
        LBAR();
        f32x4 o[2][2];
        {
            bf16x8 q2[2][4], af[2][2];
#pragma unroll
            for (int i = 0; i < 2; ++i) {
#pragma unroll
                for (int ks = 0; ks < 4; ++ks) q2[i][ks] = ldsfrag(QT, (2 * th + i) * 16 + fr, HP, ks * 32 + fq * 8);
#pragma unroll
                for (int ks = 0; ks < 2; ++ks) af[i][ks] = ldsfrag(AT, (2 * th + i) * 16 + fr, HP2, ks * 32 + fq * 8); }
#pragma unroll
            for (int j = 0; j < 2; ++j) { const int vb = 2 * vq + j;
                bf16x8 sf[4], vf[2];
#pragma unroll
                for (int ks = 0; ks < 4; ++ks) sf[ks] = ldsfrag(ST, vb * 16 + fr, HP, ks * 32 + fq * 8);
#pragma unroll
                for (int ks = 0; ks < 2; ++ks) vf[ks] = trfrag(VI, HP, ks, vb, lane);
#pragma unroll
                for (int i = 0; i < 2; ++i) { f32x4 a = (f32x4){0.f, 0.f, 0.f, 0.f};
#pragma unroll
                    for (int ks = 0; ks < 4; ++ks) a = __builtin_amdgcn_mfma_f32_16x16x32_bf16(sf[ks], q2[i][ks], a, 0, 0, 0);
#pragma unroll
                    for (int ks = 0; ks < 2; ++ks) a = __builtin_amdgcn_mfma_f32_16x16x32_bf16(vf[ks], af[i][ks], a, 0, 0, 0);
                    o[i][j] = a; }
            }
        }
        if (fin) {
#pragma unroll
            for (int i = 0; i < 2; ++i) { float ss = 0.f;
#pragma unroll
                for (int j = 0; j < 2; ++j) ss += (o[i][j][0] * o[i][j][0] + o[i][j][1] * o[i][j][1]) + (o[i][j][2] * o[i][j][2] + o[i][j][3] * o[i][j][3]);
                ss += __shfl_xor(ss, 16); ss += __shfl_xor(ss, 32);
                if (fq == 0) NRM[((2 * th + i) * 16 + fr) * 4 + vq] = ss; }
        }
        LBAR();
#pragma unroll
        for (int i = 0; i < 2; ++i) { const int t = (2 * th + i) * 16 + fr;
            float rstd = 1.0f;
            if (fin) { const f32x4 nr = *(const LAS f32x4*)(NRM + t * 4); rstd = 1.0f / sqrtf(((nr[0] + nr[1]) + (nr[2] + nr[3])) * (1.0f / 128.0f) + RMS_EPS); }
#pragma unroll
            for (int j = 0; j < 2; ++j) { const int v0 = (2 * vq + j) * 16 + 4 * fq;
                if (fin) { const f32x4 gn = *(const f32x4*)(gnorm + v0); const u32x2 gq = *(const LAS u32x2*)(GI + t * HP + v0);
                    const float y0 = o[i][j][0] * rstd * gn[0] * bf_lo(gq.x), y1 = o[i][j][1] * rstd * gn[1] * bf_hi(gq.x), y2 = o[i][j][2] * rstd * gn[2] * bf_lo(gq.y), y3 = o[i][j][3] * rstd * gn[3] * bf_hi(gq.y);
                    *(LAS u32x2*)(OI + t * HP + v0) = (u32x2){cvt_pk_bf16(y0, y1), cvt_pk_bf16(y2, y3)}; }
                else *(LAS u32x2*)(OI + t * HP + v0) = (u32x2){cvt_pk_bf16(o[i][j][0], o[i][j][1]), cvt_pk_bf16(o[i][j][2], o[i][j][3])}; }
        }
#pragma unroll
        for (int i = 0; i < 2; ++i) { const f32x4 er = *(const LAS f32x4*)(CS + 256 + (2 * kq + i) * 16 + 4 * fq);
#pragma unroll
            for (int j = 0; j < 4; ++j) { const f32x4 sv = S[i][j] * er;
                *(LAS u32x2*)(ST + ((4 * vh + j) * 16 + fr) * HP + (2 * kq + i) * 16 + 4 * fq) = (u32x2){cvt_pk_bf16(sv[0], sv[1]), cvt_pk_bf16(sv[2], sv[3])}; } }
        LBAR();
#pragma unroll
        for (int i = 0; i < 2; ++i) { const int r = prow + 32 * i; const u32x4 w = *(const LAS u32x4*)(OI + r * HP + pch * 8);
            if (fin) *(u32x4*)(Y + (rowbase + c * 64 + r) * D + hc + pch * 8) = w; else *(u32x4*)(OL + TILE_OFF(h, rowbase + c * 64 + r) + pch * 8) = w; }
    }
#undef HG_LOAD
    const int uu = (b * 4 + h) * 4 + seg;
#pragma unroll
    for (int i = 0; i < 2; ++i)
#pragma unroll
        for (int j = 0; j < 4; ++j) *(f32x4*)(SL + (size_t)uu * 16384 + ((4 * vh + j) * 16 + fr) * 128 + (2 * kq + i) * 16 + 4 * fq) = S[i][j];
    if (tid < 128) DL[uu * 128 + tid] = dk;
    LBAR();
}

__device__ __forceinline__ void hgrn_pass2(LAS unsigned char* lds, const bf16_t* QTg, const bf16_t* GHg, const float* EBg, const float* ERg, const bf16_t* OL, const float* SL, const float* DL,
                                           bf16_t* Y, const float* gnorm, int b, int h, int seg) {
    const int tid = otid(), wave = __builtin_amdgcn_readfirstlane(tid >> 6), lane = tid & 63, fr = lane & 15, fq = lane >> 4;
    LAS bf16_t* QT = (LAS bf16_t*)(lds + H_QT); LAS bf16_t* LI = (LAS bf16_t*)(lds + H_KT); LAS bf16_t* GI = (LAS bf16_t*)(lds + H_GI); LAS bf16_t* OI = (LAS bf16_t*)(lds + H_OI);
    LAS bf16_t* ST = (LAS bf16_t*)(lds + H_ST); LAS float* CS = (LAS float*)(lds + H_C); LAS float* NRM = (LAS float*)(lds + H_NRM);
    const size_t rowbase = (size_t)b * SEQ; const int hc = h * 128, c0 = seg * 8, c1 = c0 + 8, uu0 = (b * 4 + h) * 4;
    f32x4 S[8];
#pragma unroll
    for (int kb = 0; kb < 8; ++kb) S[kb] = (f32x4){0.f, 0.f, 0.f, 0.f};
    for (int j = 0; j < seg; ++j) {
#pragma unroll
        for (int kb = 0; kb < 8; ++kb) { const f32x4 dj = *(const f32x4*)(DL + (uu0 + j) * 128 + kb * 16 + 4 * fq), lj = *(const f32x4*)(SL + (size_t)(uu0 + j) * 16384 + (wave * 16 + fr) * 128 + kb * 16 + 4 * fq);
            S[kb] = S[kb] * dj + lj; }
    }
    const int tb = wave >> 1, wh = wave & 1, trow = tb * 16 + fr;
    const int csel = tid >> 7, ck = tid & 127, prow = tid >> 4, pch = tid & 15;
    const size_t cgb = rowbase >> 6;
    { const f32x4* erp = (const f32x4*)(ERg + (cgb + c0) * 512 + hc);
#pragma unroll
      for (int kb = 0; kb < 8; ++kb) { const f32x4 er = erp[kb * 4 + fq]; const f32x4 sv = S[kb] * er;
          *(LAS u32x2*)(ST + (wave * 16 + fr) * HP + kb * 16 + 4 * fq) = (u32x2){cvt_pk_bf16(sv[0], sv[1]), cvt_pk_bf16(sv[2], sv[3])}; } }
    if (tid < 256) CS[(c0 & 1) * 256 + tid] = csel == 0 ? EBg[(cgb + c0) * 512 + hc + ck] : ERg[(cgb + c0 + 1) * 512 + hc + ck];
    u32x4 tq[2], tl[2], tg[2];
#define P2_LOAD(c) do { const size_t o_ = TILE_OFF(h, rowbase + (size_t)(c) * 64) + (size_t)tid * 8; _Pragma("unroll") for (int i_ = 0; i_ < 2; ++i_) { \
        tq[i_] = *(const u32x4*)(QTg + o_ + 4096 * i_); tl[i_] = *(const u32x4*)(OL + o_ + 4096 * i_); tg[i_] = *(const u32x4*)(GHg + o_ + 4096 * i_); } } while (0)
    P2_LOAD(c0);
    for (int c = c0; c < c1; ++c) {
#pragma unroll
        for (int i = 0; i < 2; ++i) { const int o = (prow + 32 * i) * HP + pch * 8; *(LAS u32x4*)(QT + o) = tq[i]; *(LAS u32x4*)(LI + o) = tl[i]; *(LAS u32x4*)(GI + o) = tg[i]; }
        float cnext = 0.f;
        if (c + 1 < c1) {
            P2_LOAD(c + 1);
            if (tid < 256) cnext = csel == 0 ? EBg[(cgb + c + 1) * 512 + hc + ck] : (c + 2 < c1 ? ERg[(cgb + c + 2) * 512 + hc + ck] : 0.f);
        }
        LBAR();
        f32x4 o[4];
        {
            bf16x8 qf[4];
#pragma unroll
            for (int ks = 0; ks < 4; ++ks) qf[ks] = ldsfrag(QT, trow, HP, ks * 32 + fq * 8);
#pragma unroll
            for (int x = 0; x < 4; ++x) { const int vb = 4 * wh + x; const u32x2 ol = *(const LAS u32x2*)(LI + trow * HP + vb * 16 + 4 * fq);
                f32x4 a = (f32x4){bf_lo(ol.x), bf_hi(ol.x), bf_lo(ol.y), bf_hi(ol.y)};
#pragma unroll
                for (int ks = 0; ks < 4; ++ks) a = __builtin_amdgcn_mfma_f32_16x16x32_bf16(ldsfrag(ST, vb * 16 + fr, HP, ks * 32 + fq * 8), qf[ks], a, 0, 0, 0);
                o[x] = a; }
        }
        float ss = 0.f;
#pragma unroll
        for (int x = 0; x < 4; ++x) ss += (o[x][0] * o[x][0] + o[x][1] * o[x][1]) + (o[x][2] * o[x][2] + o[x][3] * o[x][3]);
        ss += __shfl_xor(ss, 16); ss += __shfl_xor(ss, 32);
        if (fq == 0) NRM[trow * 2 + wh] = ss;
        LBAR();
        {
            const float tot = NRM[trow * 2] + NRM[trow * 2 + 1];
            const float rstd = 1.0f / sqrtf(tot * (1.0f / 128.0f) + RMS_EPS);
#pragma unroll
            for (int x = 0; x < 4; ++x) { const int v0 = (4 * wh + x) * 16 + 4 * fq; const f32x4 gn = *(const f32x4*)(gnorm + v0); const u32x2 gq = *(const LAS u32x2*)(GI + trow * HP + v0);
                const float y0 = o[x][0] * rstd * gn[0] * bf_lo(gq.x), y1 = o[x][1] * rstd * gn[1] * bf_hi(gq.x), y2 = o[x][2] * rstd * gn[2] * bf_lo(gq.y), y3 = o[x][3] * rstd * gn[3] * bf_hi(gq.y);
                *(LAS u32x2*)(OI + trow * HP + v0) = (u32x2){cvt_pk_bf16(y0, y1), cvt_pk_bf16(y2, y3)}; }
        }
        if (c + 1 < c1) {
            const LAS float* cs = CS + (c & 1) * 256;
#pragma unroll
            for (int kb = 0; kb < 8; ++kb) { const f32x4 eb = *(const LAS f32x4*)(cs + kb * 16 + 4 * fq), er = *(const LAS f32x4*)(cs + 128 + kb * 16 + 4 * fq);
                S[kb] = S[kb] * eb; const f32x4 sv = S[kb] * er;
                *(LAS u32x2*)(ST + (wave * 16 + fr) * HP + kb * 16 + 4 * fq) = (u32x2){cvt_pk_bf16(sv[0], sv[1]), cvt_pk_bf16(sv[2], sv[3])}; }
            if (tid < 256) CS[((c + 1) & 1) * 256 + tid] = cnext;
        }
        LBAR();
#pragma unroll
        for (int i = 0; i < 2; ++i) { const int r = prow + 32 * i; *(u32x4*)(Y + (rowbase + c * 64 + r) * D + hc + pch * 8) = *(const LAS u32x4*)(OI + r * HP + pch * 8); }
    }
    LBAR();
#undef P2_LOAD
}

constexpr int T_WL = 0, T_VN = 36864, T_UI = 73728, T_LNC = 110592;
__device__ __forceinline__ void tmlp_units(LAS unsigned char* lds, const bf16_t* UU, const bf16_t* VV, bf16_t* Y, const bf16_t* Wsp, const float* lng, const float* lnb, const float* bsp, int i0, int i1, int st) {
    const int tid = otid(), wave = __builtin_amdgcn_readfirstlane(tid >> 6), lane = tid & 63, fr = lane & 15, fq = lane >> 4;
    LAS bf16_t* WL = (LAS bf16_t*)(lds + T_WL); LAS bf16_t* VN = (LAS bf16_t*)(lds + T_VN); LAS bf16_t* UI = (LAS bf16_t*)(lds + T_UI); LAS float* LNC = (LAS float*)(lds + T_LNC);
    if (i0 >= i1) return;
    const int s = tid >> 2, qd = tid & 3, c0 = wave * 16 + 4 * fq;
    u32x4 tu[4], tv[4];
#define TM_LOAD(i_) do { const int g_ = (i_) >> 8, bn_ = (i_) & 255; const size_t r_ = (size_t)(bn_ >> 4) * SEQ + (bn_ & 15) * 128; const bf16_t* up_ = UU + TILE_OFF(g_, r_) + (size_t)tid * 8; \
        const bf16_t* vp_ = VV + TILE_OFF(g_, r_ + s) + qd * 32; _Pragma("unroll") for (int j_ = 0; j_ < 4; ++j_) { tu[j_] = *(const u32x4*)(up_ + 4096 * j_); tv[j_] = *(const u32x4*)(vp_ + 8 * j_); } } while (0)
    TM_LOAD(i0);
    int gcur = -1;
    for (int i = i0; i < i1; i += st) {
        const int g = i >> 8, bn = i & 255; const size_t r0 = (size_t)(bn >> 4) * SEQ + (bn & 15) * 128;
        if (g != gcur) {
            const bf16_t* wg = Wsp + (size_t)g * 128 * 128;
#pragma unroll
            for (int j = 0; j < 4; ++j) { const int p = tid + 512 * j; *(LAS u32x4*)(WL + (p >> 4) * HP + (p & 15) * 8) = *(const u32x4*)(wg + (p >> 4) * 128 + (p & 15) * 8); }
            if (tid < 384) LNC[tid] = (tid < 128 ? lng : tid < 256 ? lnb : bsp)[g * 128 + (tid & 127)];
            gcur = g;
            LBAR();
        }
        {
            float v[32];
#pragma unroll
            for (int j = 0; j < 4; ++j) { const u32x4 w = tv[j]; v[8 * j] = bf_lo(w.x); v[8 * j + 1] = bf_hi(w.x); v[8 * j + 2] = bf_lo(w.y); v[8 * j + 3] = bf_hi(w.y); v[8 * j + 4] = bf_lo(w.z); v[8 * j + 5] = bf_hi(w.z); v[8 * j + 6] = bf_lo(w.w); v[8 * j + 7] = bf_hi(w.w); }
#pragma unroll
            for (int j = 0; j < 4; ++j) { const int p = tid + 512 * j; *(LAS u32x4*)(UI + (p >> 4) * HP + (p & 15) * 8) = tu[j]; }
            if (i + st < i1) TM_LOAD(i + st);
            float sm = 0.f;
#pragma unroll
            for (int j = 0; j < 32; ++j) sm += v[j];
            sm += __shfl_xor(sm, 1); sm += __shfl_xor(sm, 2);
            const float mu = sm * (1.0f / 128.0f); float sq = 0.f;
#pragma unroll
            for (int j = 0; j < 32; ++j) { v[j] -= mu; sq += v[j] * v[j]; }
            sq += __shfl_xor(sq, 1); sq += __shfl_xor(sq, 2);
            const float rstd = 1.0f / sqrtf(sq * (1.0f / 128.0f) + LN_EPS);
            const LAS f32x4* gp = (const LAS f32x4*)(LNC + qd * 32); const LAS f32x4* bp = (const LAS f32x4*)(LNC + 128 + qd * 32);
#pragma unroll
            for (int j = 0; j < 4; ++j) { const f32x4 g0 = gp[2 * j], g1 = gp[2 * j + 1], b0 = bp[2 * j], b1 = bp[2 * j + 1];
                u32x4 w; w.x = cvt_pk_bf16(v[8 * j] * rstd * g0[0] + b0[0], v[8 * j + 1] * rstd * g0[1] + b0[1]); w.y = cvt_pk_bf16(v[8 * j + 2] * rstd * g0[2] + b0[2], v[8 * j + 3] * rstd * g0[3] + b0[3]);
                w.z = cvt_pk_bf16(v[8 * j + 4] * rstd * g1[0] + b1[0], v[8 * j + 5] * rstd * g1[1] + b1[1]); w.w = cvt_pk_bf16(v[8 * j + 6] * rstd * g1[2] + b1[2], v[8 * j + 7] * rstd * g1[3] + b1[3]);
                *(LAS u32x4*)(VN + s * HP + qd * 32 + 8 * j) = w; }
        }
        LBAR();
        bf16x8 vf[4];
#pragma unroll
        for (int ks = 0; ks < 4; ++ks) vf[ks] = trfrag(VN, HP, ks, wave, lane);
#pragma unroll
        for (int tb = 0; tb < 8; ++tb) {
            f32x4 a = (f32x4){0.f, 0.f, 0.f, 0.f};
#pragma unroll
            for (int ks = 0; ks < 4; ++ks) if (ks <= (tb >> 1)) a = __builtin_amdgcn_mfma_f32_16x16x32_bf16(vf[ks], ldsfrag(WL, tb * 16 + fr, HP, ks * 32 + fq * 8), a, 0, 0, 0);
            LAS u32x2* up = (LAS u32x2*)(UI + (tb * 16 + fr) * HP + c0); const u32x2 uu = *up; const float bias = LNC[256 + tb * 16 + fr];
            const float y0 = bf_lo(uu.x) * (a[0] + bias), y1 = bf_hi(uu.x) * (a[1] + bias), y2 = bf_lo(uu.y) * (a[2] + bias), y3 = bf_hi(uu.y) * (a[3] + bias);
            *up = (u32x2){cvt_pk_bf16(y0, y1), cvt_pk_bf16(y2, y3)};
        }
        LBAR();
#pragma unroll
        for (int j = 0; j < 4; ++j) { const int p = tid + 512 * j, r = p >> 4, ch = p & 15; *(u32x4*)(Y + (r0 + r) * D + 512 + g * 128 + ch * 8) = *(const LAS u32x4*)(UI + r * HP + ch * 8); }
        LBAR();
    }
#undef TM_LOAD
}
constexpr int NPHASE = 18;
typedef __attribute__((address_space(4))) const Args CArgs;
__device__ __forceinline__ CArgs* kargs() { CArgs* p = (CArgs*)__builtin_amdgcn_kernarg_segment_ptr(); asm volatile("" : "+s"(p)); return p; }
#define WSP_(T, off) ((T*)(ws + (off)))

__device__ __forceinline__ void grid_seam(LAS unsigned char* lds) {
    CArgs* ap = kargs();
    XcdBarrier b; b.bar = (unsigned*)(ap->ws + WS_CTL) + CW_BAR; b.x = xb_xcc_id(); b.st = (volatile LAS unsigned*)(lds + MISC_OFF) + 8;
    xcd_barrier(b);
}

__device__ __forceinline__ void phase_prologue(LAS unsigned char* lds) {
    CArgs* ap = kargs(); unsigned char* ws = ap->ws;
    const int tid = otid(), lane = tid & 63, wave = __builtin_amdgcn_readfirstlane(tid >> 6), G = gridDim.x, blk = blockIdx.x;
    const int gw = blk * 8 + wave, NGW = G * 8;
    bf16_t* WIN = WSP_(bf16_t, WS_WIN); bf16_t* WOUT = WSP_(bf16_t, WS_WOUT); bf16_t* W13 = WSP_(bf16_t, WS_W13); bf16_t* WD = WSP_(bf16_t, WS_WD);
    bf16_t* WR = WSP_(bf16_t, WS_WR); bf16_t* WSP = WSP_(bf16_t, WS_WSP); float* RSTD1 = WSP_(float, WS_RSTD1); bf16_t* XSA = WSP_(bf16_t, WS_XSA);
    constexpr int I_IN = 16 * 48, I_OUT = 16 * 16;
    for (int it = gw; it < NLAYER * (I_IN + I_OUT); it += NGW) {
        const int l = it / (I_IN + I_OUT), r = it % (I_IN + I_OUT);
        if (r < I_IN) { const int kb = r / 48, nb = r % 48, n0 = nb * 64; int dr = n0;
            if (n0 < 2048) { const int seg = n0 >> 9, hh = (n0 >> 7) & 3, k = n0 & 127; dr = (4 * (seg >> 1) + hh) * 256 + (seg & 1) * 128 + k; }
            conv_tile64(ap->w_in + (size_t)l * D * DIN, DIN, kb * 64, n0, ap->norm_mix + l * D, WIN + (size_t)l * DIN * D, D, dr, lane); }
        else { const int q = r - I_IN, kb = q / 16, nb = q % 16; conv_tile64(ap->w_out + (size_t)l * D * D, D, kb * 64, nb * 64, nullptr, WOUT + (size_t)l * D * D, D, nb * 64, lane); }
    }
    for (int i = blk * 512 + tid; i < NLAYER * 48 * D; i += G * 512) { const int l = i / (48 * D), q = i % (48 * D), row = q / D, k = q % D;
        float w = 0.f; if (row < 32) w = ap->wr_e[(size_t)l * D * 32 + k * 32 + row]; else if (row < 36) w = ap->wr_g[(size_t)l * D * 4 + k * 4 + (row - 32)];
        w *= ap->norm_ffn[l * D + k];
        const unsigned hb = cvt_pk_bf16(w, 0.f) & 0xffffu; const float lo_ = w - __uint_as_float(hb << 16);
        WR[(size_t)(l * 2 + 0) * 48 * D + row * D + k] = (bf16_t)hb; WR[(size_t)(l * 2 + 1) * 48 * D + row * D + k] = (bf16_t)(cvt_pk_bf16(lo_, 0.f) & 0xffffu); }
    for (int i = blk * 512 + tid; i < NLAYER * 4 * 128 * 128; i += G * 512) { const int t = (i >> 7) & 127, s = i & 127; const float w = (s <= t) ? ap->w_sp[i] : 0.f; WSP[i] = (bf16_t)(cvt_pk_bf16(w, 0.f) & 0xffffu); }
    const float* x = ap->x;
    for (int m = gw; m < M; m += NGW) {
        const float* xr = x + (size_t)m * D + 8 * lane; float ss = 0.f; u32x4 pk[2];
#pragma unroll
        for (int j = 0; j < 2; ++j) { const f32x4 v0 = *(const f32x4*)(xr + 512 * j), v1 = *(const f32x4*)(xr + 512 * j + 4);
            pk[j].x = cvt_pk_bf16(v0.x, v0.y); pk[j].y = cvt_pk_bf16(v0.z, v0.w); pk[j].z = cvt_pk_bf16(v1.x, v1.y); pk[j].w = cvt_pk_bf16(v1.z, v1.w);
            const float a0 = bf_lo(pk[j].x), a1 = bf_hi(pk[j].x), a2 = bf_lo(pk[j].y), a3 = bf_hi(pk[j].y), a4 = bf_lo(pk[j].z), a5 = bf_hi(pk[j].z), a6 = bf_lo(pk[j].w), a7 = bf_hi(pk[j].w);
            ss += ((a0 * a0 + a1 * a1) + (a2 * a2 + a3 * a3)) + ((a4 * a4 + a5 * a5) + (a6 * a6 + a7 * a7)); }
        ss = wave_sum(ss);
        bf16_t* o = XSA + (size_t)m * D + 8 * lane;
#pragma unroll
        for (int j = 0; j < 2; ++j) *(u32x4*)(o + 512 * j) = pk[j];
        if (lane == 0) RSTD1[m] = 1.0f / sqrtf(ss * (1.0f / D) + RMS_EPS);
    }
}

struct ConvHook {
    const float* w_gate; const float* w_up; const float* w_down; const float* gain; bf16_t* W13l; bf16_t* WDl; int gw, ngw;
    __device__ __forceinline__ void operator()(int ui) const {
        if ((ui & 1) == 0 && ui < 6) { const int lane = (int)__builtin_amdgcn_mbcnt_hi(~0u, __builtin_amdgcn_mbcnt_lo(~0u, 0u)); const int it0 = (ui >> 1) * ngw + gw;
            conv_expert_weights(w_gate, w_up, w_down, gain, W13l, WDl, it0, 6144 * 4, lane, it0 + 1); }
    }
};
template <int LAYER> __device__ __forceinline__ void phase_in(LAS unsigned char* lds) {
    CArgs* ap = kargs(); unsigned char* ws = ap->ws;
    pg8::DenseOrder S; S.init(LAYER ? WSP_(bf16_t, WS_XSB) : WSP_(bf16_t, WS_XSA), WSP_(bf16_t, WS_WIN) + (size_t)LAYER * DIN * D, M, DIN, D, gridDim.x, blockIdx.x);
    unsigned char* ob = (unsigned char*)ap->out;
    LAS float* rsl = (LAS float*)(lds + TAB_OFF);
    { const int tid = otid(); const float* rstd = WSP_(float, WS_RSTD1); const float* ssq = (LAYER > 0 && gridDim.x == 256) ? WSP_(float, WS_SSQ) : nullptr;
      for (int i = 0; i < 8; ++i) { pg8::Unit u; if (!S.next(i, u)) break;
          if (tid < 256) { const int r = u.pm * 256 + tid; float v;
              if (ssq) { const f32x4* p = (const f32x4*)(ssq + (size_t)r * 16); const f32x4 a = p[0], b = p[1], c = p[2], d = p[3];
                  const float t = ((a[0] + a[1]) + (a[2] + a[3])) + ((b[0] + b[1]) + (b[2] + b[3])) + (((c[0] + c[1]) + (c[2] + c[3])) + ((d[0] + d[1]) + (d[2] + d[3])));
                  v = 1.0f / sqrtf(t * (1.0f / D) + RMS_EPS); }
              else v = rstd[r];
              rsl[i * 256 + tid] = v; } }
      __syncthreads(); }
    EpiIn E{WSP_(bf16_t, WS_QT), WSP_(bf16_t, WS_KT), WSP_(bf16_t, WS_VH), WSP_(bf16_t, WS_GH), (bf16_t*)(ob + OUT_U), (bf16_t*)(ob + OUT_V), WSP_(float, WS_EB), WSP_(float, WS_ER), WSP_(float, WS_EK),
            rsl, ap->lb_logits, LAYER};
    if (LAYER == 0 && gridDim.x == 256) {
        const int t_ = otid(), wave = __builtin_amdgcn_readfirstlane(t_ >> 6);
        ConvHook H{ap->w_gate, ap->w_up, ap->w_down, ap->norm_ffn, WSP_(bf16_t, WS_W13), WSP_(bf16_t, WS_WD), (int)blockIdx.x * 8 + wave, 2048};
        pg8::gemm_phase<EpiIn, pg8::DenseOrder, false, ConvHook>(lds, D, S, E, nullptr, H);
    } else pg8::gemm_phase<EpiIn, pg8::DenseOrder, false>(lds, D, S, E, nullptr);
}

template <int LAYER> __device__ __forceinline__ void phase_mixer_a(LAS unsigned char* lds, int rep) {
    CArgs* ap = kargs(); unsigned char* ws = ap->ws;
    const int sel = rep ? MK_MIXSEL : 15;
    const int G = gridDim.x, blk = blockIdx.x;
    unsigned char* ob = (unsigned char*)ap->out; bf16_t* YB = (bf16_t*)(ob + OUT_Y);
    if (sel & 1) { const float* gn = ap->hgrn_norm + LAYER * 128;
        for (int u = blk; u < 256; u += G) hgrn_pass1(lds, WSP_(bf16_t, WS_QT), WSP_(bf16_t, WS_KT), WSP_(bf16_t, WS_VH), WSP_(bf16_t, WS_GH), WSP_(float, WS_EB), WSP_(float, WS_ER), WSP_(float, WS_EK),
                                                      WSP_(bf16_t, WS_OL), WSP_(float, WS_SL), WSP_(float, WS_DL), YB, gn, u >> 4, (u >> 2) & 3, u & 3); }
    if ((sel & 4) && LAYER == 0 && G != 256) { const int t_ = otid(), wave = __builtin_amdgcn_readfirstlane(t_ >> 6), lane = t_ & 63;
        conv_expert_weights(ap->w_gate + (size_t)LAYER * NEXP * D * DEXP, ap->w_up + (size_t)LAYER * NEXP * D * DEXP, ap->w_down + (size_t)LAYER * NEXP * DEXP * D, ap->norm_ffn + LAYER * D,
                            WSP_(bf16_t, WS_W13) + (size_t)LAYER * NEXP * 512 * D, WSP_(bf16_t, WS_WD) + (size_t)LAYER * NEXP * D * DEXP, blk * 8 + wave, G * 8, lane); }
}
template <int LAYER> __device__ __forceinline__ void phase_mixer_b(LAS unsigned char* lds, int rep) {
    CArgs* ap = kargs(); unsigned char* ws = ap->ws;
    const int sel = rep ? MK_MIXSEL : 15;
    const int G = gridDim.x, blk = blockIdx.x;
    unsigned char* ob = (unsigned char*)ap->out; bf16_t* YB = (bf16_t*)(ob + OUT_Y);
    if (sel & 8) { const float* gn = ap->hgrn_norm + LAYER * 128;
        for (int j = blk; j < 192; j += G) { const int bh = j / 3, seg = 1 + j % 3;
            hgrn_pass2(lds, WSP_(bf16_t, WS_QT), WSP_(bf16_t, WS_GH), WSP_(float, WS_EB), WSP_(float, WS_ER), WSP_(bf16_t, WS_OL), WSP_(float, WS_SL), WSP_(float, WS_DL), YB, gn, bh >> 2, bh & 3, seg); } }
    if (sel & 2) {
        const bf16_t* wsp = WSP_(bf16_t, WS_WSP) + (size_t)LAYER * 4 * 128 * 128; const float* lng = ap->ln_g + LAYER * 512; const float* lnb = ap->ln_b + LAYER * 512; const float* bsp = ap->b_sp + LAYER * 512;
        int i0, i1, st;
        if (G == 256) { if (blk < 192) { i0 = 2 * blk; i1 = i0 + 2; } else { i0 = 384 + 10 * (blk - 192); i1 = i0 + 10; } st = 1; }
        else { i0 = blk; i1 = 1024; st = G; }
        __syncthreads();
        tmlp_units(lds, (const bf16_t*)(ob + OUT_U), (const bf16_t*)(ob + OUT_V), YB, wsp, lng, lnb, bsp, i0, i1, st);
    }
}

template <int LAYER> __device__ __forceinline__ void phase_out(LAS unsigned char* lds, int rep) {
    CArgs* ap = kargs(); unsigned char* ws = ap->ws;
    pg8::DenseOrder S; S.init(ap->out, WSP_(bf16_t, WS_WOUT) + (size_t)LAYER * D * D, M, D, D, gridDim.x, blockIdx.x);
    bf16_t* xs = LAYER ? WSP_(bf16_t, WS_XSB) : WSP_(bf16_t, WS_XSA);
    EpiOut E{xs, rep ? WSP_(bf16_t, WS_Z) : xs};
    pg8::gemm_phase<EpiOut, pg8::DenseOrder, false>(lds, D, S, E, nullptr);
}

constexpr int R_P = 0, R_HIST = 100352, R_BASE = R_HIST + 256, R_REC = R_BASE + 256, R_H2 = R_REC + 4096, R_B2 = R_H2 + 1024;
template <int LAYER> __device__ __forceinline__ void phase_router(LAS unsigned char* lds, int rep) {
    CArgs* ap = kargs(); unsigned char* ws = ap->ws;
    const int tid = otid(), lane = tid & 63, wave = __builtin_amdgcn_readfirstlane(tid >> 6), G = gridDim.x, blk = blockIdx.x;
    const bf16_t* XC = LAYER ? WSP_(bf16_t, WS_XSB) : WSP_(bf16_t, WS_XSA);
    unsigned* cnt = WSP_(unsigned, WS_CTL) + CW_CNT + LAYER * 64 * 64;
    int* LIST = WSP_(int, WS_LIST); float* RSV = WSP_(float, WS_RS); float* WTV = WSP_(float, WS_WT); int* TOKC = WSP_(int, WS_TOKC);
    const bf16_t* wrh = WSP_(bf16_t, WS_WR) + (size_t)(LAYER * 2) * 48 * D; const bf16_t* wrl = wrh + 48 * D;
    LAS float* P = (LAS float*)(lds + R_P); LAS unsigned* hist = (LAS unsigned*)(lds + R_HIST); LAS unsigned* basel = (LAS unsigned*)(lds + R_BASE); LAS unsigned* REC = (LAS unsigned*)(lds + R_REC);
    LAS unsigned* hist2 = (LAS unsigned*)(lds + R_H2); LAS unsigned* base2 = (LAS unsigned*)(lds + R_B2);
    unsigned* cnt2 = WSP_(unsigned, WS_CTL) + CW_CNT2 + LAYER * 256 * 64; int* CLIST = WSP_(int, WS_CLIST);
    if (blk == 0 && tid < 128) ((unsigned*)((unsigned char*)ap->out + OUT_HID + (size_t)ZROW * DEXP * 2))[tid] = 0u;
    const int fr = lane & 15, fq = lane >> 4;
    bf16x8 bh[3][4], bl[3][4];
#pragma unroll
    for (int nt = 0; nt < 3; ++nt)
#pragma unroll
        for (int ks = 0; ks < 4; ++ks) { const size_t o = (size_t)(nt * 16 + fr) * D + 128 * wave + ks * 32 + fq * 8; bh[nt][ks] = *(const bf16x8*)(wrh + o); bl[nt][ks] = *(const bf16x8*)(wrl + o); }
    for (int rp = blk; rp < M / 128; rp += G) {
        if (tid < 32) hist[tid] = 0u;
        if (tid < 256) hist2[tid] = 0u;
#pragma unroll 1
        for (int r = 0; r < 2; ++r) {
#pragma unroll 1
            for (int j = 0; j < 4; ++j) {
                const bf16_t* xrow = XC + (size_t)(rp * 128 + (4 * r + j) * 16 + fr) * D + 128 * wave + fq * 8;
                u32x4 aw[4];
#pragma unroll
                for (int ks = 0; ks < 4; ++ks) aw[ks] = *(const u32x4*)(xrow + ks * 32);
                f32x4 acc[3]; float ss = 0.f;
#pragma unroll
                for (int i = 0; i < 3; ++i) acc[i] = (f32x4){0.f, 0.f, 0.f, 0.f};
#pragma unroll
                for (int ks = 0; ks < 4; ++ks) {
                    { const float a0 = bf_lo(aw[ks].x), a1 = bf_hi(aw[ks].x), a2 = bf_lo(aw[ks].y), a3 = bf_hi(aw[ks].y), a4 = bf_lo(aw[ks].z), a5 = bf_hi(aw[ks].z), a6 = bf_lo(aw[ks].w), a7 = bf_hi(aw[ks].w);
                      ss += ((a0 * a0 + a1 * a1) + (a2 * a2 + a3 * a3)) + ((a4 * a4 + a5 * a5) + (a6 * a6 + a7 * a7)); }
                    const bf16x8 af = __builtin_bit_cast(bf16x8, aw[ks]);
#pragma unroll
                    for (int nt = 0; nt < 3; ++nt) { acc[nt] = __builtin_amdgcn_mfma_f32_16x16x32_bf16(af, bh[nt][ks], acc[nt], 0, 0, 0); acc[nt] = __builtin_amdgcn_mfma_f32_16x16x32_bf16(af, bl[nt][ks], acc[nt], 0, 0, 0); }
                }
                ss += __shfl_xor(ss, 16); ss += __shfl_xor(ss, 32);
                LAS float* pw = P + (wave * 4 + j) * 16 * 49;
#pragma unroll
                for (int nt = 0; nt < 3; ++nt)
#pragma unroll
                    for (int i = 0; i < 4; ++i) pw[(4 * fq + i) * 49 + nt * 16 + fr] = acc[nt][i];
                if (fq == 0) pw[fr * 49 + 48] = ss;
            }
            __syncthreads();
            if (wave < 4 && lane < 16) {
                float gl[4] = {0.f, 0.f, 0.f, 0.f}; float ss = 0.f;
                const LAS float* pr0 = P + (wave * 16 + lane) * 49;
#pragma unroll
                for (int w = 0; w < 8; ++w) { const LAS float* pr = pr0 + w * (4 * 16 * 49);
#pragma unroll
                    for (int c = 0; c < 4; ++c) gl[c] += pr[32 + c];
                    ss += pr[48]; }
                const float rstd = 1.0f / sqrtf(ss * (1.0f / D) + RMS_EPS);
                int gi = 0;
#pragma unroll
                for (int c = 0; c < 4; ++c) gl[c] *= rstd;
                float gm = gl[0];
#pragma unroll
                for (int c = 1; c < 4; ++c) if (gl[c] > gm) { gm = gl[c]; gi = c; }
                float den = 0.f;
#pragma unroll
                for (int c = 0; c < 4; ++c) den += fexp(gl[c] - gm);
                const float psel = 1.0f / den;
                float ev[8] = {0.f, 0.f, 0.f, 0.f, 0.f, 0.f, 0.f, 0.f};
#pragma unroll
                for (int w = 0; w < 8; ++w) { const LAS float* pr = pr0 + w * (4 * 16 * 49) + gi * 8;
#pragma unroll
                    for (int c = 0; c < 8; ++c) ev[c] += pr[c]; }
#pragma unroll
                for (int c = 0; c < 8; ++c) ev[c] *= rstd;
                int i1 = 0; float v1 = ev[0];
#pragma unroll
                for (int c = 1; c < 8; ++c) if (ev[c] > v1) { v1 = ev[c]; i1 = c; }
                int i2 = -1; float v2 = -3.0e38f;
#pragma unroll
                for (int c = 0; c < 8; ++c) if (c != i1 && ev[c] > v2) { v2 = ev[c]; i2 = c; }
                const float w1 = psel / (1.0f + fexp(v2 - v1)), w2 = psel - w1;
                const int e1 = gi * 8 + i1, e2 = gi * 8 + i2;
                const int elo = e1 < e2 ? e1 : e2, ehi = e1 < e2 ? e2 : e1; const float wlo = e1 < e2 ? w1 : w2, whi = e1 < e2 ? w2 : w1;
                const unsigned r1 = __hip_atomic_fetch_add(hist + elo, 1u, __ATOMIC_RELAXED, __HIP_MEMORY_SCOPE_WORKGROUP);
                const unsigned r2 = __hip_atomic_fetch_add(hist + ehi, 1u, __ATOMIC_RELAXED, __HIP_MEMORY_SCOPE_WORKGROUP);
                LAS unsigned* rec = REC + ((4 * r + wave) * 16 + lane) * 8;
                const unsigned r3 = __hip_atomic_fetch_add(hist2 + elo * 8 + (ehi & 7), 1u, __ATOMIC_RELAXED, __HIP_MEMORY_SCOPE_WORKGROUP);
                rec[0] = (unsigned)elo; rec[1] = r1; rec[2] = (unsigned)ehi; rec[3] = r2; rec[7] = r3; rec[4] = __float_as_uint(wlo); rec[5] = __float_as_uint(whi); rec[6] = __float_as_uint(rstd);
            }
            __syncthreads();
        }
        if (tid < 32) { const unsigned n = hist[tid]; basel[tid] = n ? __hip_atomic_fetch_add(cnt + tid * 64, n, __ATOMIC_RELAXED, __HIP_MEMORY_SCOPE_AGENT) : 0u; }
        if (tid < 256) { const unsigned n = hist2[tid]; base2[tid] = n ? __hip_atomic_fetch_add(cnt2 + tid * 64, n, __ATOMIC_RELAXED, __HIP_MEMORY_SCOPE_AGENT) : 0u; }
        __syncthreads();
        if (tid < 128) {
            const LAS unsigned* rec = REC + tid * 8; const int token = rp * 128 + tid;
            const unsigned c1 = rec[0], s1 = basel[c1] + rec[1], c2 = rec[2], s2 = basel[c2] + rec[3]; const float rstd = __uint_as_float(rec[6]);
            if (s1 < (unsigned)LISTCAP) { const size_t o = (size_t)c1 * LISTCAP + s1; LIST[o] = token; RSV[o] = rstd; WTV[o] = __uint_as_float(rec[4]); }
            if (s2 < (unsigned)LISTCAP) { const size_t o = (size_t)c2 * LISTCAP + s2; LIST[o] = token; RSV[o] = rstd; WTV[o] = __uint_as_float(rec[5]); }
            *(u32x4*)(TOKC + (size_t)token * 4) = (u32x4){c1, s1, c2, s2};
            { const unsigned cls = c1 * 8 + (c2 & 7), s3 = base2[cls] + rec[7]; if (s3 < (unsigned)CLCAP) CLIST[cls * CLCAP + s3] = token; }
        }
        __syncthreads();
    }
}

__device__ __forceinline__ void moe_tables(LAS int* pre, LAS int* cntl, const unsigned* cnt, int tid) {
    __syncthreads();
    if (tid < 32) { unsigned v = __hip_atomic_load(cnt + tid * 64, __ATOMIC_RELAXED, __HIP_MEMORY_SCOPE_AGENT); if (v > (unsigned)LISTCAP) v = LISTCAP; cntl[tid] = (int)v; }
    __syncthreads();
    if (tid == 0) { int a = 0; for (int c = 0; c < 32; ++c) { pre[c] = a; a += (cntl[c] + 255) >> 8; } pre[32] = a; }
    __syncthreads();
}
template <int LAYER, int WHICH> __device__ __forceinline__ void phase_moe(LAS unsigned char* lds, int rep) {
    CArgs* ap = kargs(); unsigned char* ws = ap->ws;
    const int tid = otid(), G = gridDim.x, blk = blockIdx.x;
    LAS int* tab = (LAS int*)(lds + TAB_OFF); LAS int* pre = (LAS int*)(lds + MOE_OFF); LAS int* cntl = pre + 80;
    const int* LIST = WSP_(int, WS_LIST);
    const bf16_t* XC = LAYER ? WSP_(bf16_t, WS_XSB) : WSP_(bf16_t, WS_XSA);
    bf16_t* HID = (bf16_t*)((unsigned char*)ap->out + OUT_HID);
    moe_tables(pre, cntl, WSP_(unsigned, WS_CTL) + CW_CNT + LAYER * 64 * 64, tid);
    if (WHICH == 0) {
        MoeOrder S{pre, cntl, (const char*)XC, (const char*)(WSP_(bf16_t, WS_W13) + (size_t)LAYER * NEXP * 512 * D), 0, 32, 2, G, blk, 0, (size_t)512 * D * 2, (size_t)256 * D * 2, true};
        for (int i = 0; i < 4; ++i) { pg8::Unit u; if (!S.next(i, u)) break; if (tid < 256) tab[i * 256 + tid] = tid < u.nvalid ? LIST[u.lbase + tid] : 0; }
        __syncthreads();
        EpiMoe1 E{HID, WSP_(float, WS_RS), WSP_(float, WS_WT)};
        pg8::gemm_phase<EpiMoe1, MoeOrder, true>(lds, D, S, E, tab);
        if (LAYER + 1 < NLAYER && rep == 0) {
            const int total = pre[32] * 2, rem = total % G, P = rem ? G - rem : G, rank = rem ? blk - rem : blk;
            if (rank >= 0) { const int t_ = otid(), wave = __builtin_amdgcn_readfirstlane(t_ >> 6), lane = t_ & 63; constexpr int NL = LAYER + 1;
                conv_expert_weights(ap->w_gate + (size_t)NL * NEXP * D * DEXP, ap->w_up + (size_t)NL * NEXP * D * DEXP, ap->w_down + (size_t)NL * NEXP * DEXP * D, ap->norm_ffn + NL * D,
                                    WSP_(bf16_t, WS_W13) + (size_t)NL * NEXP * 512 * D, WSP_(bf16_t, WS_WD) + (size_t)NL * NEXP * D * DEXP, rank * 8 + wave, P * 8, lane); }
        }
    } else {
        MoeOrder S{pre, cntl, (const char*)HID, (const char*)(WSP_(bf16_t, WS_WD) + (size_t)LAYER * NEXP * D * DEXP), 0, 32, 4, G, blk, (size_t)256 * DEXP * 2, (size_t)D * DEXP * 2, (size_t)256 * DEXP * 2, false};
        EpiMoe2 E{WSP_(bf16_t, WS_EO)};
        pg8::gemm_phase<EpiMoe2, MoeOrder, false>(lds, DEXP, S, E, tab);
    }
}

constexpr int PT_TAB = 131072, PT_TOK = PT_TAB + 16384, PT_MISC = PT_TOK + 2048;
struct EpiPair {
    const bf16_t* XC; bf16_t* XO; float* SSQ; const LAS int* tok;
    __device__ __forceinline__ void operator()(const f32x4 (&acc)[2][2][4][2], const pg8::Unit& u, int wr, int wc, int fr, int fq) const {
        const int lr0 = wr * 64 + fr, col0 = u.pn * 256 + wc * 32 + 8 * fq;
#pragma unroll
        for (int ai = 0; ai < 2; ++ai)
#pragma unroll
            for (int m = 0; m < 4; ++m) {
                const int lr = lr0 + ai * 128 + m * 16; const int token = tok[u.pm * 256 + lr]; const size_t off = (size_t)token * D + col0; float ss = 0.f;
#pragma unroll
                for (int bj = 0; bj < 2; ++bj) {
                    const u32x4 o = *(const u32x4*)(XC + off + bj * 128);
                    const f32x4 a0 = acc[ai][bj][m][0], a1 = acc[ai][bj][m][1];
                    u32x4 w; w.x = cvt_pk_bf16(bf_lo(o.x) + a0[0], bf_hi(o.x) + a0[1]); w.y = cvt_pk_bf16(bf_lo(o.y) + a0[2], bf_hi(o.y) + a0[3]);
                    w.z = cvt_pk_bf16(bf_lo(o.z) + a1[0], bf_hi(o.z) + a1[1]); w.w = cvt_pk_bf16(bf_lo(o.w) + a1[2], bf_hi(o.w) + a1[3]);
                    *(u32x4*)(XO + off + bj * 128) = w;
                    const float b0 = bf_lo(w.x), b1 = bf_hi(w.x), b2 = bf_lo(w.y), b3 = bf_hi(w.y), b4 = bf_lo(w.z), b5 = bf_hi(w.z), b6 = bf_lo(w.w), b7 = bf_hi(w.w);
                    ss += ((b0 * b0 + b1 * b1) + (b2 * b2 + b3 * b3)) + ((b4 * b4 + b5 * b5) + (b6 * b6 + b7 * b7));
                }
                ss += __shfl_xor(ss, 16); ss += __shfl_xor(ss, 32);
                if (fq == 0) SSQ[(size_t)token * 16 + u.pn * 4 + wc] = ss;
            }
    }
};
struct PairOrder {
    const LAS int* nb; const LAS int* el; const char* hid; const char* wd; int nun, sub;
    __device__ bool next(int i, pg8::Unit& u) const {
        int uu = 0, b = i;
        if (nun > 1 && b >= nb[0]) { b -= nb[0]; uu = 1; }
        if (uu >= nun || b >= nb[uu]) return false;
        u.pm = uu; u.pn = sub; u.nvalid = 256; u.lbase = 0; u.slot = uu * 8 + b; u.fin = (b == nb[uu] - 1);
        u.A = hid; u.B = wd + (size_t)el[uu * 8 + b] * ((size_t)D * DEXP * 2) + (size_t)sub * ((size_t)256 * DEXP * 2);
        return true;
    }
};
template <int LAYER> __device__ __forceinline__ void phase_pair(LAS unsigned char* lds) {
    CArgs* ap = kargs(); unsigned char* ws = ap->ws;
    const int tid = otid(), G = gridDim.x, blk = blockIdx.x;
    LAS int* tabA = (LAS int*)(lds + PT_TAB); LAS int* tokl = (LAS int*)(lds + PT_TOK); LAS int* misc = (LAS int*)(lds + PT_MISC);
    LAS int* pre = misc; LAS int* cntl = misc + 40; LAS int* cpre = misc + 72; LAS int* nbl = misc + 332; LAS int* ell = misc + 334; LAS unsigned* maskl = (LAS unsigned*)(misc + 350);
    const bf16_t* XC = LAYER ? WSP_(bf16_t, WS_XSB) : WSP_(bf16_t, WS_XSA); bf16_t* XO = LAYER ? WSP_(bf16_t, WS_XSA) : WSP_(bf16_t, WS_XSB);
    const bf16_t* HID = (const bf16_t*)((unsigned char*)ap->out + OUT_HID);
    const int* CLIST = WSP_(int, WS_CLIST); const int* TOKC = WSP_(int, WS_TOKC);
    moe_tables(pre, cntl, WSP_(unsigned, WS_CTL) + CW_CNT + LAYER * 64 * 64, tid);
    if (tid < 256) { unsigned v = __hip_atomic_load(WSP_(unsigned, WS_CTL) + CW_CNT2 + (LAYER * 256 + tid) * 64, __ATOMIC_RELAXED, __HIP_MEMORY_SCOPE_AGENT); if (v > (unsigned)CLCAP) v = CLCAP; cpre[tid + 1] = (int)v; }
    if (tid == 0) { cpre[0] = 0; maskl[0] = 0u; maskl[1] = 0u; }
    __syncthreads();
    if (tid == 0) { int a = 0; for (int c = 1; c <= 256; ++c) { a += cpre[c]; cpre[c] = a; } }
    __syncthreads();
    LAS int* tnb = misc + 352; LAS int* ord = misc + 480;
    if (tid < 128) { const int p0 = 256 * tid, p1 = p0 + 256; int lo = 0, hi = 256;
        while (hi - lo > 1) { const int mid = (lo + hi) >> 1; if (cpre[mid] <= p0) lo = mid; else hi = mid; }
        unsigned mk = 0u; for (int c = lo; c < 256 && cpre[c] < p1; ++c) if (cpre[c + 1] > cpre[c] && cpre[c + 1] > p0) { const int e0 = c >> 3, e1 = (e0 & ~7) | (c & 7); mk |= (1u << e0) | (1u << e1); }
        int n = __builtin_popcount(mk); tnb[tid] = n > 8 ? 8 : n; }
    __syncthreads();
    if (tid == 0) { int k = 0; for (int v = 8; v >= 0; --v) for (int t = 0; t < 128; ++t) if (tnb[t] == v) ord[k++] = t; }
    __syncthreads();
    const int nun = 2, sub = blk & 3; const int utile[2] = {ord[blk >> 2], ord[127 - (blk >> 2)]};
    int elo[2] = {0, 0}, ehi[2] = {0, 0}, rlo[2] = {0, 0}, rhi[2] = {0, 0};
#pragma unroll
    for (int uu = 0; uu < 2; ++uu) {
        if (uu < nun && tid < 256) {
            const int t = utile[uu], p = 256 * t + tid;
            int lo = 0, hi = 256;
            while (hi - lo > 1) { const int mid = (lo + hi) >> 1; if (cpre[mid] <= p) lo = mid; else hi = mid; }
            int token = 0; if (p < cpre[256]) token = CLIST[lo * CLCAP + (p - cpre[lo])];
            const u32x4 tc = *(const u32x4*)(TOKC + (size_t)token * 4);
            elo[uu] = (int)tc.x; ehi[uu] = (int)tc.z; rlo[uu] = pre[tc.x] * 256 + (int)tc.y; rhi[uu] = pre[tc.z] * 256 + (int)tc.w;
            tokl[uu * 256 + tid] = token;
            __hip_atomic_fetch_or(maskl + uu, (1u << elo[uu]) | (1u << ehi[uu]), __ATOMIC_RELAXED, __HIP_MEMORY_SCOPE_WORKGROUP);
        }
    }
    __syncthreads();
    if (tid < 2) { unsigned mk = maskl[tid]; int n = 0; while (mk && n < 8) { const int e = __builtin_ctz(mk); mk &= mk - 1; ell[tid * 8 + n] = e; ++n; } nbl[tid] = n; }
    __syncthreads();
#pragma unroll
    for (int uu = 0; uu < 2; ++uu) {
        if (uu < nun && tid < 256) { const int n = nbl[uu];
            for (int b = 0; b < n; ++b) { const int e = ell[uu * 8 + b]; tabA[(uu * 8 + b) * 256 + tid] = (elo[uu] == e) ? rlo[uu] : (ehi[uu] == e) ? rhi[uu] : ZROW; } }
    }
    __syncthreads();
    PairOrder S{nbl, ell, (const char*)HID, (const char*)(WSP_(bf16_t, WS_WD) + (size_t)LAYER * NEXP * D * DEXP), nun, sub};
    EpiPair E{XC, XO, WSP_(float, WS_SSQ), tokl};
    pg8::gemm_phase<EpiPair, PairOrder, true>(lds, DEXP, S, E, tabA);
}

template <int LAYER> __device__ __forceinline__ void phase_combine(LAS unsigned char* lds) {
    CArgs* ap = kargs(); unsigned char* ws = ap->ws;
    const int tid = otid(), lane = tid & 63, wave = __builtin_amdgcn_readfirstlane(tid >> 6), G = gridDim.x, blk = blockIdx.x;
    const int gw = blk * 8 + wave, NGW = G * 8;
    LAS int* pre = (LAS int*)(lds + MOE_OFF); LAS int* cntl = pre + 80;
    moe_tables(pre, cntl, WSP_(unsigned, WS_CTL) + CW_CNT + LAYER * 64 * 64, tid);
    const bf16_t* XC = LAYER ? WSP_(bf16_t, WS_XSB) : WSP_(bf16_t, WS_XSA); bf16_t* XO = LAYER ? WSP_(bf16_t, WS_XSA) : WSP_(bf16_t, WS_XSB);
    const bf16_t* EO = WSP_(bf16_t, WS_EO); const int* TOKC = WSP_(int, WS_TOKC); float* RSTD1 = WSP_(float, WS_RSTD1);
    const float* gf = ap->norm_final; float* out = ap->out;
    const unsigned poison = (__hip_atomic_load(WSP_(unsigned, WS_CTL) + CW_BAR + XB_TMO, __ATOMIC_RELAXED, __HIP_MEMORY_SCOPE_AGENT) != 0u);
    for (int m = gw; m < M; m += NGW) {
        const u32x4 tc = *(const u32x4*)(TOKC + (size_t)m * 4);
        const size_t ga = (size_t)(pre[tc.x] * 256 + (int)tc.y), gb = (size_t)(pre[tc.z] * 256 + (int)tc.w);
        const bf16_t* xr = XC + (size_t)m * D + 8 * lane; const bf16_t* ea = EO + ga * D + 8 * lane; const bf16_t* eb = EO + gb * D + 8 * lane;
        float v[16]; float ss = 0.f;
#pragma unroll
        for (int j = 0; j < 2; ++j) { const u32x4 x = *(const u32x4*)(xr + 512 * j), a = *(const u32x4*)(ea + 512 * j), b = *(const u32x4*)(eb + 512 * j);
            v[8 * j] = bf_lo(x.x) + bf_lo(a.x) + bf_lo(b.x); v[8 * j + 1] = bf_hi(x.x) + bf_hi(a.x) + bf_hi(b.x); v[8 * j + 2] = bf_lo(x.y) + bf_lo(a.y) + bf_lo(b.y); v[8 * j + 3] = bf_hi(x.y) + bf_hi(a.y) + bf_hi(b.y);
            v[8 * j + 4] = bf_lo(x.z) + bf_lo(a.z) + bf_lo(b.z); v[8 * j + 5] = bf_hi(x.z) + bf_hi(a.z) + bf_hi(b.z); v[8 * j + 6] = bf_lo(x.w) + bf_lo(a.w) + bf_lo(b.w); v[8 * j + 7] = bf_hi(x.w) + bf_hi(a.w) + bf_hi(b.w); }
        if (LAYER + 1 < NLAYER) {
            u32x4 pk[2];
#pragma unroll
            for (int j = 0; j < 2; ++j) { pk[j].x = cvt_pk_bf16(v[8 * j], v[8 * j + 1]); pk[j].y = cvt_pk_bf16(v[8 * j + 2], v[8 * j + 3]); pk[j].z = cvt_pk_bf16(v[8 * j + 4], v[8 * j + 5]); pk[j].w = cvt_pk_bf16(v[8 * j + 6], v[8 * j + 7]);
                const float a0 = bf_lo(pk[j].x), a1 = bf_hi(pk[j].x), a2 = bf_lo(pk[j].y), a3 = bf_hi(pk[j].y), a4 = bf_lo(pk[j].z), a5 = bf_hi(pk[j].z), a6 = bf_lo(pk[j].w), a7 = bf_hi(pk[j].w);
                ss += ((a0 * a0 + a1 * a1) + (a2 * a2 + a3 * a3)) + ((a4 * a4 + a5 * a5) + (a6 * a6 + a7 * a7)); }
            ss = wave_sum(ss);
            bf16_t* o = XO + (size_t)m * D + 8 * lane;
#pragma unroll
            for (int j = 0; j < 2; ++j) *(u32x4*)(o + 512 * j) = pk[j];
            if (lane == 0) RSTD1[m] = 1.0f / sqrtf(ss * (1.0f / D) + RMS_EPS);
        } else {
#pragma unroll
            for (int i = 0; i < 16; ++i) ss += v[i] * v[i];
            ss = wave_sum(ss);
            float rstd = 1.0f / sqrtf(ss * (1.0f / D) + RMS_EPS);
            if (poison) rstd = __builtin_nanf("");
            float* o = out + (size_t)m * D + 8 * lane;
#pragma unroll
            for (int j = 0; j < 2; ++j) { const f32x4 g0 = *(const f32x4*)(gf + 512 * j + 8 * lane), g1 = *(const f32x4*)(gf + 512 * j + 8 * lane + 4);
                *(f32x4*)(o + 512 * j) = (f32x4){v[8 * j] * rstd * g0[0], v[8 * j + 1] * rstd * g0[1], v[8 * j + 2] * rstd * g0[2], v[8 * j + 3] * rstd * g0[3]};
                *(f32x4*)(o + 512 * j + 4) = (f32x4){v[8 * j + 4] * rstd * g1[0], v[8 * j + 5] * rstd * g1[1], v[8 * j + 6] * rstd * g1[2], v[8 * j + 7] * rstd * g1[3]}; }
        }
    }
}

__device__ __forceinline__ void phase_rownorm(LAS unsigned char* lds) {
    CArgs* ap = kargs(); unsigned char* ws = ap->ws;
    const int tid = otid(), lane = tid & 63, wave = __builtin_amdgcn_readfirstlane(tid >> 6), G = gridDim.x, blk = blockIdx.x;
    const int gw = blk * 8 + wave, NGW = G * 8;
    const bf16_t* XO = WSP_(bf16_t, WS_XSB); float* RSTD1 = WSP_(float, WS_RSTD1);
    for (int m = gw; m < M; m += NGW) {
        const u32x4* xr = (const u32x4*)(XO + (size_t)m * D) + lane; float ss = 0.f;
#pragma unroll
        for (int j = 0; j < 2; ++j) { const u32x4 w = xr[64 * j];
            const float a0 = bf_lo(w.x), a1 = bf_hi(w.x), a2 = bf_lo(w.y), a3 = bf_hi(w.y), a4 = bf_lo(w.z), a5 = bf_hi(w.z), a6 = bf_lo(w.w), a7 = bf_hi(w.w);
            ss += ((a0 * a0 + a1 * a1) + (a2 * a2 + a3 * a3)) + ((a4 * a4 + a5 * a5) + (a6 * a6 + a7 * a7)); }
        ss = wave_sum(ss);
        if (lane == 0) RSTD1[m] = 1.0f / sqrtf(ss * (1.0f / D) + RMS_EPS);
    }
}

__device__ __forceinline__ void phase_final(LAS unsigned char* lds) {
    CArgs* ap = kargs(); unsigned char* ws = ap->ws;
    const int tid = otid(), lane = tid & 63, wave = __builtin_amdgcn_readfirstlane(tid >> 6), G = gridDim.x, blk = blockIdx.x;
    const int gw = blk * 8 + wave, NGW = G * 8;
    const bf16_t* XF = WSP_(bf16_t, WS_XSA);
    const float* gf = ap->norm_final; float* out = ap->out;
    const unsigned poison = (__hip_atomic_load(WSP_(unsigned, WS_CTL) + CW_BAR + XB_TMO, __ATOMIC_RELAXED, __HIP_MEMORY_SCOPE_AGENT) != 0u);
    for (int m = gw; m < M; m += NGW) {
        const u32x4* xr = (const u32x4*)(XF + (size_t)m * D) + lane; float v[16]; float ss = 0.f;
#pragma unroll
        for (int j = 0; j < 2; ++j) { const u32x4 w = xr[64 * j];
            v[8 * j] = bf_lo(w.x); v[8 * j + 1] = bf_hi(w.x); v[8 * j + 2] = bf_lo(w.y); v[8 * j + 3] = bf_hi(w.y); v[8 * j + 4] = bf_lo(w.z); v[8 * j + 5] = bf_hi(w.z); v[8 * j + 6] = bf_lo(w.w); v[8 * j + 7] = bf_hi(w.w); }
#pragma unroll
        for (int i = 0; i < 16; ++i) ss += v[i] * v[i];
        ss = wave_sum(ss);
        float rstd = 1.0f / sqrtf(ss * (1.0f / D) + RMS_EPS);
        if (poison) rstd = __builtin_nanf("");
        f32x4* o = (f32x4*)(out + (size_t)m * D);
#pragma unroll
        for (int j = 0; j < 2; ++j) { const int c = (64 * j + lane) * 8; const f32x4 g0 = *(const f32x4*)(gf + c), g1 = *(const f32x4*)(gf + c + 4);
            o[(c >> 2)] = (f32x4){v[8 * j] * rstd * g0[0], v[8 * j + 1] * rstd * g0[1], v[8 * j + 2] * rstd * g0[2], v[8 * j + 3] * rstd * g0[3]};
            o[(c >> 2) + 1] = (f32x4){v[8 * j + 4] * rstd * g1[0], v[8 * j + 5] * rstd * g1[1], v[8 * j + 6] * rstd * g1[2], v[8 * j + 7] * rstd * g1[3]}; }
    }
}

#define IN(k) (lo <= (k) && (k) < hi)
#define SEAM(k) do { if (IN(k) && IN((k) + 1)) grid_seam(lds); } while (0)
#define REPS(bit) (((MK_REPEAT) >> (bit)) & 1)
template <int LAYER> __device__ __forceinline__ void layer_program(LAS unsigned char* lds, const int lo, const int hi) {
    constexpr int pb = 8 * LAYER;
    if (IN(pb + 1)) {
#pragma unroll 1
        for (int rep = 0; rep <= REPS(1); ++rep) { if (rep) grid_seam(lds); phase_in<LAYER>(lds); } }
    SEAM(pb + 1);
    if (IN(pb + 2)) {
#pragma unroll 1
        for (int rep = 0; rep <= REPS(2); ++rep) { if (rep) grid_seam(lds); phase_mixer_a<LAYER>(lds, rep); grid_seam(lds); phase_mixer_b<LAYER>(lds, rep); } }
    SEAM(pb + 2);
    if (IN(pb + 3)) {
#pragma unroll 1
        for (int rep = 0; rep <= REPS(3); ++rep) { if (rep) grid_seam(lds); phase_out<LAYER>(lds, rep); } }
    SEAM(pb + 3);
    if (IN(pb + 4)) {
#pragma unroll 1
        for (int rep = 0; rep <= REPS(4); ++rep) { if (rep) grid_seam(lds); phase_router<LAYER>(lds, rep); } }
    SEAM(pb + 4);
    if (IN(pb + 5)) {
#pragma unroll 1
        for (int rep = 0; rep <= REPS(5); ++rep) { if (rep) grid_seam(lds); phase_moe<LAYER, 0>(lds, rep); } }
    SEAM(pb + 5);
    const bool pair = (LAYER + 1 < NLAYER) && gridDim.x == 256;
    if (IN(pb + 6)) {
        if (pair) {
#pragma unroll 1
            for (int rep = 0; rep <= REPS(6); ++rep) { if (rep) grid_seam(lds); phase_pair<LAYER>(lds); } }
        else {
#pragma unroll 1
        for (int rep = 0; rep <= REPS(6); ++rep) { if (rep) grid_seam(lds); phase_moe<LAYER, 1>(lds, rep); } } }
    SEAM(pb + 6);
    if (!pair) {
    if (IN(pb + 7)) {
#pragma unroll 1
        for (int rep = 0; rep <= REPS(7); ++rep) { if (rep) grid_seam(lds); phase_combine<LAYER>(lds); } }
    if (LAYER + 1 < NLAYER) { if (IN(pb + 7) && IN(pb + 9)) grid_seam(lds); }
    }
}

__global__ void __launch_bounds__(512, 2) fwd_kernel(Args args) {
    extern __shared__ __attribute__((aligned(16))) unsigned char lds_raw[];
    LAS unsigned char* lds = (LAS unsigned char*)lds_raw;
    volatile LAS unsigned* MISC = (volatile LAS unsigned*)(lds + MISC_OFF);
    if (threadIdx.x < 64) MISC[threadIdx.x] = 0u;
    __syncthreads();
    const int lo = kargs()->ph_lo, hi = kargs()->ph_hi;
    if (!MK_PER_PHASE) (void)xcd_barrier_post((unsigned*)(kargs()->ws + WS_CTL) + CW_BAR, MISC + 8);
    if (IN(0)) {
#pragma unroll 1
        for (int rep = 0; rep <= REPS(0); ++rep) { if (rep) grid_seam(lds); phase_prologue(lds); } }
    SEAM(0);
#pragma unroll 1
    for (int i = 0; i < MK_XSEAM; ++i) grid_seam(lds);
    layer_program<0>(lds, lo, hi);
    layer_program<1>(lds, lo, hi);
}
#undef IN
#undef SEAM

extern "C" void kernel_launch(void* const* d_in, const int* in_sizes, int n_in, void* d_out, int out_size, void* d_ws, size_t ws_size, hipStream_t stream) {
    static int grid = 0;
    if (grid == 0) {
        if (n_in != 17 || in_sizes[0] != M * D || out_size != M * D || ws_size < WS_END) { fprintf(stderr, "kernel_launch: unexpected shapes (n_in %d, in0 %d, out %d, ws %zu; need ws >= %zu); nothing launched\n", n_in, n_in > 0 ? in_sizes[0] : -1, out_size, ws_size, (size_t)WS_END); grid = -1; return; }
        int dev = 0, cus = 0, per_cu = 0;
        if (hipGetDevice(&dev) != hipSuccess || hipDeviceGetAttribute(&cus, hipDeviceAttributeMultiprocessorCount, dev) != hipSuccess) { grid = -1; return; }
        if (hipFuncSetAttribute((const void*)fwd_kernel, hipFuncAttributeMaxDynamicSharedMemorySize, LDS_BYTES) != hipSuccess) { fprintf(stderr, "kernel_launch: hipFuncSetAttribute failed\n"); grid = -1; return; }
        if (hipOccupancyMaxActiveBlocksPerMultiprocessor(&per_cu, (const void*)fwd_kernel, 512, LDS_BYTES) != hipSuccess || per_cu < 1) { fprintf(stderr, "kernel_launch: occupancy query says %d blocks per CU\n", per_cu); }
        (void)hipGetLastError();
        grid = cus;
    }
    if (grid < 0) return;
    if (hipMemsetAsync((char*)d_ws + WS_CTL, 0, CTL_ZERO_BYTES, stream) != hipSuccess) return;
    Args a{};
    a.x = (const float*)d_in[0]; a.lb_logits = (const float*)d_in[1]; a.norm_mix = (const float*)d_in[2]; a.w_in = (const float*)d_in[3]; a.hgrn_norm = (const float*)d_in[4];
    a.ln_g = (const float*)d_in[5]; a.ln_b = (const float*)d_in[6]; a.w_sp = (const float*)d_in[7]; a.b_sp = (const float*)d_in[8]; a.w_out = (const float*)d_in[9];
    a.norm_ffn = (const float*)d_in[10]; a.wr_g = (const float*)d_in[11]; a.wr_e = (const float*)d_in[12]; a.w_gate = (const float*)d_in[13]; a.w_up = (const float*)d_in[14];
    a.w_down = (const float*)d_in[15]; a.norm_final = (const float*)d_in[16]; a.out = (float*)d_out; a.ws = (unsigned char*)d_ws;
#if MK_PER_PHASE
    for (int p = 0; p < NPHASE; ++p) { if (p == 16) continue; a.ph_lo = p; a.ph_hi = p + 1; hipLaunchKernelGGL(fwd_kernel, dim3(grid), dim3(512), LDS_BYTES, stream, a); }
#else
    a.ph_lo = 0; a.ph_hi = NPHASE;
    hipLaunchKernelGGL(fwd_kernel, dim3(grid), dim3(512), LDS_BYTES, stream, a);
#endif
}
```

```cpp
#include <hip/hip_runtime.h>
#include <cstdio>
#include <cstdint>

#ifndef MK_REPEAT
#define MK_REPEAT 0
#endif
#ifndef MK_MIXSEL
#define MK_MIXSEL 15
#endif
#ifndef MK_XSEAM
#define MK_XSEAM 0
#endif
#ifndef MK_PER_PHASE
#define MK_PER_PHASE 0
#endif

#define LAS __attribute__((address_space(3)))
#define GAS __attribute__((address_space(1)))
typedef unsigned short bf16_t;
typedef short bf16x8 __attribute__((ext_vector_type(8)));
typedef float f32x4 __attribute__((ext_vector_type(4)));
typedef float f32x2 __attribute__((ext_vector_type(2)));
typedef unsigned u32x4 __attribute__((ext_vector_type(4)));
typedef unsigned u32x2 __attribute__((ext_vector_type(2)));
typedef GAS unsigned gu32;

constexpr int BATCH = 16, SEQ = 2048, D = 1024, M = BATCH * SEQ, DIN = 3072;
constexpr int NEXP = 32, DEXP = 256, NLAYER = 2;
constexpr float RMS_EPS = 1e-6f, LN_EPS = 1e-5f;
#define TILE_OFF(h_, row_) (((size_t)(h_) * M + (size_t)(row_)) * 128)
constexpr int LISTCAP = 32768;

constexpr size_t MiB = 1u << 20;
constexpr size_t WS_CTL = 0, CTL_ZERO_BYTES = 1 * MiB;
constexpr size_t WS_WIN = 1 * MiB;
constexpr size_t WS_WOUT = 13 * MiB;
constexpr size_t WS_W13 = 17 * MiB;
constexpr size_t WS_WD = 81 * MiB;
constexpr size_t WS_WR = 113 * MiB;
constexpr size_t WS_WSP = 113 * MiB + 512 * 1024;
constexpr size_t WS_RSTD1 = 114 * MiB;
constexpr size_t WS_LIST = 115 * MiB;
constexpr size_t WS_RS = 123 * MiB;
constexpr size_t WS_WT = 131 * MiB;
constexpr size_t WS_XSA = 140 * MiB;
constexpr size_t WS_XSB = 204 * MiB;
constexpr size_t WS_Z = 268 * MiB;
constexpr size_t WS_QT = WS_Z, WS_KT = WS_Z + 32 * MiB, WS_VH = WS_Z + 64 * MiB, WS_GH = WS_Z + 96 * MiB;
constexpr size_t WS_EB = WS_Z + 128 * MiB, WS_ER = WS_Z + 129 * MiB, WS_EK = WS_Z + 130 * MiB;
constexpr size_t WS_OL = WS_Z + 136 * MiB;
constexpr size_t WS_SL = WS_Z + 168 * MiB;
constexpr size_t WS_DL = WS_Z + 184 * MiB;
constexpr size_t OUT_Y = 0, OUT_U = 64 * MiB, OUT_V = 96 * MiB;
constexpr size_t WS_EO = WS_Z;
constexpr size_t OUT_HID = 0;
constexpr size_t WS_CLIST = 135 * MiB;
constexpr size_t WS_SSQ = 137 * MiB;
constexpr int CLCAP = 2048, ZROW = 320 * 256;
constexpr int CW_CNT2 = 65536;
constexpr size_t WS_TOKC = 123 * MiB + 4 * MiB;
constexpr size_t WS_END = 460 * MiB;
constexpr int CW_TMO = 0, CW_CODE = 1, CW_BAR = 4096, CW_CNT = 16384;

constexpr int RING_BYTES = 131072;
constexpr int TAB_OFF = 131072;
constexpr int MOE_OFF = TAB_OFF + 4096;
constexpr int LDS_BYTES = 155648;
constexpr int MISC_OFF = LDS_BYTES - 256;

__device__ __forceinline__ unsigned cvt_pk_bf16(float lo, float hi) { unsigned r; asm volatile("v_cvt_pk_bf16_f32 %0, %1, %2" : "=v"(r) : "v"(lo), "v"(hi)); return r; }
__device__ __forceinline__ int otid() { int t = (int)threadIdx.x; asm volatile("" : "+v"(t)); return t; }
__device__ __forceinline__ float bf_lo(unsigned u) { return __uint_as_float(u << 16); }
__device__ __forceinline__ float bf_hi(unsigned u) { return __uint_as_float(u & 0xffff0000u); }
__device__ __forceinline__ float bf1(bf16_t u) { return __uint_as_float((unsigned)u << 16); }
__device__ __forceinline__ float fexp2(float x) { return __builtin_amdgcn_exp2f(x); }
__device__ __forceinline__ float fexp(float x) { return __builtin_amdgcn_exp2f(x * 1.4426950408889634f); }
__device__ __forceinline__ float frcp(float x) { return __builtin_amdgcn_rcpf(x); }
__device__ __forceinline__ float silu_f(float x) { return x * frcp(1.0f + fexp(-x)); }
__device__ __forceinline__ float wave_sum(float v) {
#pragma unroll
    for (int o = 1; o < 64; o <<= 1) v += __shfl_xor(v, o);
    return v;
}
__device__ __forceinline__ float gelu_f(float v) {
    const float av = __builtin_fabsf(v), d = av * 0.2316418882f + 1.0f, t = frcp(d);
    float q = t * 0.5307027145f + (-0.7265760135f); q = q * t + 0.7107068705f; q = q * t + (-0.142248368f); q = q * t + 0.127414796f; q = q * t;
    const float e = fexp2((v * v) * (-0.72134752044f));
    const float m = v * (q * e), r = v - m;
    return v < 0.f ? m : r;
}

#define XB_TMO      128
#define XB_XCNT(j)  (256  + 64 * (j))
#define XB_XSUB(j)  (1280 + 64 * (j))
#define XB_XGEN(j)  (2304 + 64 * (j))
#define XB_TOP      3328
#define XB_TOPGEN   3392
#define XCD_BAR_WORDS 3456
#define XB_SPIN_CAP (1u << 18)
__device__ __forceinline__ unsigned xb_ld(unsigned* p)              { return __hip_atomic_load(p, __ATOMIC_RELAXED, __HIP_MEMORY_SCOPE_AGENT); }
__device__ __forceinline__ unsigned xb_add(unsigned* p, unsigned v) { return __hip_atomic_fetch_add(p, v, __ATOMIC_RELAXED, __HIP_MEMORY_SCOPE_AGENT); }
__device__ __forceinline__ unsigned xb_xcc_id() { return (unsigned)__builtin_amdgcn_s_getreg((3 << 11) | 20) & 0xFu; }
#define XB_SPIN(cond, bar) do { unsigned _sp = 0; while (cond) { __builtin_amdgcn_s_sleep(1); \
    if ((++_sp & 255u) == 0u) { if (xb_ld(&(bar)[XB_TMO])) break; if (_sp > XB_SPIN_CAP) { atomicAdd(&(bar)[XB_TMO], 1u); break; } } } } while (0)
struct XcdBarrier { unsigned* bar; unsigned x; volatile LAS unsigned* st; };
__device__ __forceinline__ XcdBarrier xcd_barrier_post(unsigned* bar, volatile LAS unsigned* st) {
    XcdBarrier b; b.bar = bar; b.x = xb_xcc_id(); b.st = st;
    if (threadIdx.x == 0) (void)xb_add(&bar[XB_XCNT(b.x)], 1u);
    return b;
}
__device__ __forceinline__ void xcd_barrier_complete(unsigned* bar, unsigned x, unsigned& nloc, unsigned& nx) {
    const unsigned G = gridDim.x * gridDim.y * gridDim.z;
    unsigned sum, cnt, mine, sp = 0u;
    for (;;) {
        sum = 0u; cnt = 0u; mine = 0u;
#pragma unroll
        for (unsigned j = 0; j < 16; ++j) { const unsigned c = xb_ld(&bar[XB_XCNT(j)]); sum += c; cnt += (c > 0u) ? 1u : 0u; mine = (j == x) ? c : mine; }
        if (sum == G) break;
        __builtin_amdgcn_s_sleep(1);
        if ((++sp & 255u) == 0u) { if (xb_ld(&bar[XB_TMO])) break; if (sp > XB_SPIN_CAP) { atomicAdd(&bar[XB_TMO], 1u); break; } }
    }
    nloc = mine > 0u ? mine : 1u; nx = cnt > 0u ? cnt : 1u;
}
__device__ __forceinline__ void xcd_barrier(const XcdBarrier& b) {
    asm volatile("s_waitcnt vmcnt(0)" ::: "memory");
    __syncthreads();
    if (threadIdx.x == 0) {
        unsigned* bar = b.bar;
        __builtin_amdgcn_s_waitcnt(0);
        unsigned nloc = b.st[0], nx = b.st[1];
        if (nloc == 0u) { xcd_barrier_complete(bar, b.x, nloc, nx); b.st[0] = nloc; b.st[1] = nx; }
        const unsigned old = xb_add(&bar[XB_XSUB(b.x)], 1u);
        const unsigned gen = old / nloc;
        if (old + 1u == (gen + 1u) * nloc) {
            __builtin_amdgcn_fence(__ATOMIC_RELEASE, "agent");
            asm volatile("s_waitcnt vmcnt(0)" ::: "memory");
            const unsigned og = xb_add(&bar[XB_TOP], 1u);
            const unsigned tg = og / nx;
            if (og + 1u == (tg + 1u) * nx) xb_add(&bar[XB_TOPGEN], 1u);
            else XB_SPIN(xb_ld(&bar[XB_TOPGEN]) == tg, bar);
            __builtin_amdgcn_fence(__ATOMIC_ACQUIRE, "agent");
            xb_add(&bar[XB_XGEN(b.x)], 1u);
            asm volatile("s_waitcnt vmcnt(0)" ::: "memory");
        } else {
            XB_SPIN(xb_ld(&bar[XB_XGEN(b.x)]) == gen, bar);
            __builtin_amdgcn_fence(__ATOMIC_ACQUIRE, "agent");
            asm volatile("s_waitcnt vmcnt(0)" ::: "memory");
        }
    }
    __syncthreads();
}

namespace pg8 {
constexpr int BM = 256, BK = 64, HALF = 128, HTB = HALF * BK * 2, NXCD = 8, WGM = 8;
__host__ __device__ __forceinline__ int lds_byte(int r, int c) { const int st = (r >> 4) * 2 + (c >> 5), rr = r & 15, cc = c & 31, ob = rr * 64 + cc * 2; return st * 1024 + (ob ^ (((ob >> 9) & 1) << 5)); }
__host__ __device__ __forceinline__ void stage_rc(int b, int& R, int& C) { const int st = b / 1024, sb = b % 1024, swz = sb ^ (((sb >> 9) & 1) << 5); R = (st >> 1) * 16 + swz / 64; C = (st & 1) * 32 + (swz % 64) / 2; }
__host__ __device__ __forceinline__ int perm32(int rho) { const int n = rho >> 4, i = rho & 15; return 8 * (i >> 2) + 4 * n + (i & 3); }

struct Unit { const char* A; const char* B; int pm, pn, nvalid, lbase, slot, fin; };

struct DenseOrder {
    const char* A; const char* Bt; int nM, nN, nwg, G, c; size_t tstep;
    __device__ void init(const void* A_, const void* Bt_, int Mr, int N, int K, int G_, int c_) { A = (const char*)A_; Bt = (const char*)Bt_; nM = Mr / BM; nN = N / BM; nwg = nM * nN; G = G_; c = c_; tstep = (size_t)BM * K * 2; }
    __device__ bool next(int i, Unit& u) const {
        const long L = (long)i * G + c; if (L >= nwg) return false;
        int wgid = (int)L; { const int q = nwg / NXCD, r = nwg % NXCD, xcd = wgid % NXCD, off = wgid / NXCD; wgid = (xcd < r ? xcd * (q + 1) : r * (q + 1) + (xcd - r) * q) + off; }
        const int nig = WGM * nN, gid = wgid / nig, fm = gid * WGM, gsz = (nM - fm) < WGM ? (nM - fm) : WGM;
        u.pm = fm + ((wgid % nig) % gsz); u.pn = (wgid % nig) / gsz; u.A = A + (size_t)u.pm * tstep; u.B = Bt + (size_t)u.pn * tstep; u.nvalid = 256; u.lbase = 0; u.slot = i; u.fin = 1; return true;
    }
};

struct NoHook { __device__ __forceinline__ void operator()(int) const {} };
template <class Epi, class Sched, bool GATHER, class Hook = NoHook>
__device__ __forceinline__ void gemm_phase(LAS unsigned char* lds, const int K, const Sched& S, const Epi& E, const LAS int* tab, const Hook& H = Hook()) {
    const int tid = otid(), wid = __builtin_amdgcn_readfirstlane(tid >> 6), lane = tid & 63, wr = wid >> 2, wc = wid & 3, fr = lane & 15, fq = lane >> 4;
    const int nt = K / BK;
    unsigned voffB[2];
#pragma unroll
    for (int i = 0; i < 2; ++i) { int R_, C_; stage_rc(tid * 16 + i * 8192, R_, C_); const int Rb = (R_ & ~31) + perm32(R_ & 31); voffB[i] = (unsigned)(Rb * K + C_) * 2u; }
    const size_t kstep = (size_t)(BK * 2);
    const size_t hstep = (size_t)HALF * K * 2;
    const unsigned ldsw = (unsigned)wid * 1024u;
    const int aoff = lds_byte(wr * 64 + fr, fq * 8), boff = lds_byte(wc * 32 + fr, fq * 8);
#define PG8_SA(b, h) (((b) * 2 + (h)) * HTB)
#define PG8_SB(b, h) ((4 + (b) * 2 + (h)) * HTB)
#define PG8_STAGE(bufoff, gbase, voff) do { _Pragma("unroll") for (int _i = 0; _i < 2; ++_i) \
        __builtin_amdgcn_global_load_lds((const unsigned*)((const char*)(gbase) + (voff)[_i]), (LAS unsigned*)(lds + (bufoff) + ldsw + _i * 8192), 16, 0, 0); } while (0)
#define PG8_LDA(dst, b, h) do { _Pragma("unroll") for (int m = 0; m < 4; ++m) _Pragma("unroll") for (int k = 0; k < 2; ++k) dst[m][k] = *(const LAS bf16x8*)(lds + PG8_SA(b, h) + aoff + m * 2048 + k * 1024); } while (0)
#define PG8_LDB(dst, b, h) do { _Pragma("unroll") for (int n = 0; n < 2; ++n) _Pragma("unroll") for (int k = 0; k < 2; ++k) dst[n][k] = *(const LAS bf16x8*)(lds + PG8_SB(b, h) + boff + n * 2048 + k * 1024); } while (0)
#define PG8_MMA(ai, bj, At, Bt) do { __builtin_amdgcn_s_setprio(1); _Pragma("unroll") for (int m = 0; m < 4; ++m) _Pragma("unroll") for (int n = 0; n < 2; ++n) _Pragma("unroll") for (int k = 0; k < 2; ++k) \
        acc[ai][bj][m][n] = __builtin_amdgcn_mfma_f32_16x16x32_bf16(Bt[n][k], At[m][k], acc[ai][bj][m][n], 0, 0, 0); __builtin_amdgcn_s_setprio(0); } while (0)
#define PG8_WAIT_V(n) asm volatile("s_waitcnt vmcnt(" #n ")" ::: "memory")
#define PG8_WAIT_L(n) asm volatile("s_waitcnt lgkmcnt(" #n ")" ::: "memory")
#define PG8_BAR __builtin_amdgcn_s_barrier()
#define PG8_SCHED __builtin_amdgcn_sched_barrier(0)
#define PG8_SETVA(dst, u) do { int _t = tid; if (GATHER) asm volatile("" : "+v"(_t)); _Pragma("unroll") for (int _i = 0; _i < 2; ++_i) { int _R, _C; stage_rc(_t * 16 + _i * 8192, _R, _C); \
        _Pragma("unroll") for (int _h = 0; _h < 2; ++_h) { const int _row = _R + 128 * _h; const int _gr = GATHER ? tab[(u).slot * 256 + _row] : _row; dst[_h][_i] = (unsigned)(_gr * K + _C) * 2u; } } } while (0)
    Unit cur, nxt; int ui = 0;
    if (!S.next(0, cur)) return;
    f32x4 acc[2][2][4][2];
#pragma unroll
    for (int a = 0; a < 2; ++a)
#pragma unroll
        for (int b = 0; b < 2; ++b)
#pragma unroll
            for (int m = 0; m < 4; ++m)
#pragma unroll
                for (int n = 0; n < 2; ++n) acc[a][b][m][n] = (f32x4){0.f, 0.f, 0.f, 0.f};
    bf16x8 At[4][2], B0[2][2], B1[2][2];
    unsigned vA[2][2];
    PG8_SETVA(vA, cur);
    const char* cA = cur.A; const char* cB = cur.B;
    PG8_STAGE(PG8_SB(0, 0), cB, voffB); PG8_STAGE(PG8_SB(0, 1), cB + hstep, voffB); PG8_STAGE(PG8_SA(0, 0), cA, vA[0]); PG8_STAGE(PG8_SA(0, 1), cA, vA[1]);
    if (wr == 1) PG8_BAR;
    PG8_WAIT_V(2); PG8_BAR;
    PG8_STAGE(PG8_SB(1, 0), cB + kstep, voffB); PG8_STAGE(PG8_SA(1, 0), cA + kstep, vA[0]); PG8_STAGE(PG8_SB(1, 1), cB + hstep + kstep, voffB);
    PG8_WAIT_V(6); PG8_BAR;
    for (;;) {
        const bool has_next = S.next(ui + 1, nxt);
        const char* nA = has_next ? nxt.A : cA; const char* nB = has_next ? nxt.B : cB;
#pragma unroll 1
        for (int t = 0; t < nt; t += 2) {
            const bool last = (t == nt - 2);
            const char* a1 = cA + (size_t)(t + 1) * kstep;
            const char* a2 = last ? nA : cA + (size_t)(t + 2) * kstep; const char* b2 = last ? nB : cB + (size_t)(t + 2) * kstep;
            const char* a3 = a2 + kstep; const char* b3 = b2 + kstep;
            PG8_LDB(B0, 0, 0); PG8_LDB(B1, 0, 1); PG8_SCHED; PG8_LDA(At, 0, 0); PG8_STAGE(PG8_SA(1, 1), a1, vA[1]);
            if (GATHER && last && has_next) { PG8_SETVA(vA, nxt); }
            PG8_WAIT_V(8); PG8_WAIT_L(0); PG8_BAR; PG8_MMA(0, 0, At, B0); PG8_MMA(0, 1, At, B1); PG8_BAR; PG8_SCHED;
            PG8_LDA(At, 0, 1); PG8_STAGE(PG8_SB(0, 0), b2, voffB); PG8_STAGE(PG8_SB(0, 1), b2 + hstep, voffB); PG8_STAGE(PG8_SA(0, 0), a2, vA[0]);
            PG8_WAIT_V(8); PG8_WAIT_L(0); PG8_BAR; PG8_MMA(1, 0, At, B0); PG8_MMA(1, 1, At, B1); PG8_BAR; PG8_SCHED;
            PG8_LDB(B0, 1, 0); PG8_LDB(B1, 1, 1); PG8_SCHED; PG8_LDA(At, 1, 0); PG8_STAGE(PG8_SA(0, 1), a2, vA[1]);
            PG8_WAIT_V(8); PG8_WAIT_L(0); PG8_BAR; PG8_MMA(0, 0, At, B0); PG8_MMA(0, 1, At, B1); PG8_BAR; PG8_SCHED;
            PG8_LDA(At, 1, 1); PG8_STAGE(PG8_SB(1, 0), b3, voffB); PG8_STAGE(PG8_SB(1, 1), b3 + hstep, voffB); PG8_STAGE(PG8_SA(1, 0), a3, vA[0]);
            PG8_WAIT_V(8); PG8_WAIT_L(0); PG8_BAR; PG8_MMA(1, 0, At, B0); PG8_MMA(1, 1, At, B1); PG8_BAR; PG8_SCHED;
        }
        if (cur.fin) {
        if (wr == 0) PG8_BAR;
        { int fr_ = fr, fq_ = fq; asm volatile("" : "+v"(fr_), "+v"(fq_)); E(acc, cur, wr, wc, fr_, fq_); }
        H(ui);
        }
        if (!has_next) break;
        if (cur.fin) {
#pragma unroll
        for (int a = 0; a < 2; ++a)
#pragma unroll
            for (int b = 0; b < 2; ++b)
#pragma unroll
                for (int m = 0; m < 4; ++m)
#pragma unroll
                    for (int n = 0; n < 2; ++n) acc[a][b][m][n] = (f32x4){0.f, 0.f, 0.f, 0.f};
        if (wr == 1) PG8_BAR;
        }
        cur = nxt; cA = nA; cB = nB; ++ui;
    }
    PG8_WAIT_V(0);
    PG8_BAR;
#undef PG8_SA
#undef PG8_SB
#undef PG8_STAGE
#undef PG8_LDA
#undef PG8_LDB
#undef PG8_MMA
#undef PG8_WAIT_V
#undef PG8_WAIT_L
#undef PG8_BAR
#undef PG8_SCHED
#undef PG8_SETVA
}
}

struct Args {
    const float* x; const float* lb_logits; const float* norm_mix; const float* w_in; const float* hgrn_norm; const float* ln_g; const float* ln_b;
    const float* w_sp; const float* b_sp; const float* w_out; const float* norm_ffn; const float* wr_g; const float* wr_e; const float* w_gate; const float* w_up; const float* w_down;
    const float* norm_final; float* out; unsigned char* ws; int ph_lo, ph_hi;
};

__device__ __forceinline__ float dpp_shr_add(float x, const int ctrl_sel) {
    int xi = __builtin_bit_cast(int, x), y;
    if (ctrl_sel == 1) y = __builtin_amdgcn_update_dpp(0, xi, 0x111, 0xf, 0xf, true);
    else if (ctrl_sel == 2) y = __builtin_amdgcn_update_dpp(0, xi, 0x112, 0xf, 0xf, true);
    else if (ctrl_sel == 4) y = __builtin_amdgcn_update_dpp(0, xi, 0x114, 0xf, 0xf, true);
    else y = __builtin_amdgcn_update_dpp(0, xi, 0x118, 0xf, 0xf, true);
    return x + __builtin_bit_cast(float, y);
}
struct EpiIn {
    bf16_t* QT; bf16_t* KT; bf16_t* VH; bf16_t* GH; bf16_t* UU; bf16_t* VV; float* EB; float* ER; float* EK; const LAS float* rsl; const float* lbl; int layer;
    __device__ __forceinline__ void operator()(const f32x4 (&acc)[2][2][4][2], const pg8::Unit& u, int wr, int wc, int fr, int fq) const {
        const int row0 = u.pm * 256 + wr * 64 + fr;
        const int cl = wc * 32 + 8 * fq;
        if (u.pn >= 8) {
            bf16_t* dst = (u.pn >= 10 ? VV : UU) + cl;
#pragma unroll
            for (int ai = 0; ai < 2; ++ai)
#pragma unroll
                for (int m = 0; m < 4; ++m) { const int r = row0 + ai * 128 + m * 16; const float rs = rsl[u.slot * 256 + (r - u.pm * 256)];
#pragma unroll
                    for (int bj = 0; bj < 2; ++bj) { float v[8];
#pragma unroll
                        for (int j = 0; j < 8; ++j) v[j] = gelu_f(acc[ai][bj][m][j >> 2][j & 3] * rs);
                        u32x4 w; w.x = cvt_pk_bf16(v[0], v[1]); w.y = cvt_pk_bf16(v[2], v[3]); w.z = cvt_pk_bf16(v[4], v[5]); w.w = cvt_pk_bf16(v[6], v[7]);
                        *(u32x4*)(dst + TILE_OFF((u.pn & 1) * 2 + bj, r)) = w; } }
        } else if (u.pn >= 4) {
            const int hh = u.pn - 4;
#pragma unroll
            for (int ai = 0; ai < 2; ++ai)
#pragma unroll
                for (int m = 0; m < 4; ++m) { const int r = row0 + ai * 128 + m * 16; const float rs = rsl[u.slot * 256 + (r - u.pm * 256)]; float v[8], g[8];
#pragma unroll
                    for (int j = 0; j < 8; ++j) { v[j] = acc[ai][0][m][j >> 2][j & 3] * rs; g[j] = silu_f(acc[ai][1][m][j >> 2][j & 3] * rs); }
                    u32x4 w; w.x = cvt_pk_bf16(v[0], v[1]); w.y = cvt_pk_bf16(v[2], v[3]); w.z = cvt_pk_bf16(v[4], v[5]); w.w = cvt_pk_bf16(v[6], v[7]);
                    *(u32x4*)(VH + TILE_OFF(hh, r) + cl) = w;
                    w.x = cvt_pk_bf16(g[0], g[1]); w.y = cvt_pk_bf16(g[2], g[3]); w.z = cvt_pk_bf16(g[4], g[5]); w.w = cvt_pk_bf16(g[6], g[7]);
                    *(u32x4*)(GH + TILE_OFF(hh, r) + cl) = w; }
        } else {
            const int hc = u.pn * 128 + cl;
            const int lane = (int)__builtin_amdgcn_mbcnt_hi(~0u, __builtin_amdgcn_mbcnt_lo(~0u, 0u));
            float lb[8];
#pragma unroll
            for (int j = 0; j < 8; ++j) lb[j] = layer ? frcp(1.0f + fexp(lbl[hc + j] - lbl[512 + hc + j])) : 0.f;
#pragma unroll
            for (int ai = 0; ai < 2; ++ai) {
                const int rowb = u.pm * 256 + ai * 128 + wr * 64, cg = rowb >> 6;
                float rs[4];
#pragma unroll
                for (int m = 0; m < 4; ++m) rs[m] = rsl[u.slot * 256 + (rowb - u.pm * 256) + 16 * m + fr];
                unsigned qp[4][4], kp[4][4];
#pragma unroll
                for (int jp = 0; jp < 4; ++jp) {
                    float qt[2][4], kt[2][4];
#pragma unroll
                    for (int jj = 0; jj < 2; ++jj) {
                        const int j = 2 * jp + jj; float q[4], kk[4], lf[4], T[4];
#pragma unroll
                        for (int m = 0; m < 4; ++m) { q[m] = silu_f(acc[ai][0][m][j >> 2][j & 3] * rs[m]);
                            const float sg = frcp(1.0f + fexp(-acc[ai][1][m][j >> 2][j & 3] * rs[m])), f = lb[j] + (1.0f - lb[j]) * sg;
                            kk[m] = 1.0f - f; float x = __builtin_amdgcn_logf(fmaxf(f, 1e-30f));
                            x = dpp_shr_add(x, 1); x = dpp_shr_add(x, 2); x = dpp_shr_add(x, 4); x = dpp_shr_add(x, 8);
                            lf[m] = x; T[m] = __shfl(x, lane | 15); }
                        const float r = T[0] + T[1], e = r + (T[2] + T[3]);
                        float carry = 0.f;
#pragma unroll
                        for (int m = 0; m < 4; ++m) { const float d = fminf(fmaxf(lf[m] + carry - r, -120.f), 120.f); carry += T[m]; qt[jj][m] = q[m] * fexp2(d); kt[jj][m] = kk[m] * fexp2(-d); }
                        if (fr == 0) { const size_t o = (size_t)cg * 512 + hc + j; EB[o] = fexp2(e); ER[o] = fexp2(r); EK[o] = fexp2(e - r); }
                    }
#pragma unroll
                    for (int m = 0; m < 4; ++m) { qp[m][jp] = cvt_pk_bf16(qt[0][m], qt[1][m]); kp[m][jp] = cvt_pk_bf16(kt[0][m], kt[1][m]); }
                }
#pragma unroll
                for (int m = 0; m < 4; ++m) { const size_t o = TILE_OFF(u.pn, rowb + 16 * m + fr) + cl;
                    *(u32x4*)(QT + o) = (u32x4){qp[m][0], qp[m][1], qp[m][2], qp[m][3]}; *(u32x4*)(KT + o) = (u32x4){kp[m][0], kp[m][1], kp[m][2], kp[m][3]}; }
            }
        }
    }
};
struct EpiOut {
    const bf16_t* XS; bf16_t* XD;
    __device__ __forceinline__ void operator()(const f32x4 (&acc)[2][2][4][2], const pg8::Unit& u, int wr, int wc, int fr, int fq) const {
        const int row0 = u.pm * 256 + wr * 64 + fr, col0 = u.pn * 256 + wc * 32 + 8 * fq;
#pragma unroll
        for (int ai = 0; ai < 2; ++ai)
#pragma unroll
            for (int m = 0; m < 4; ++m) {
                const size_t ro = (size_t)(row0 + ai * 128 + m * 16) * D + col0; const bf16_t* srcp = XS + ro; bf16_t* rowp = XD + ro;
#pragma unroll
                for (int bj = 0; bj < 2; ++bj) {
                    const u32x4 o = *(const u32x4*)(srcp + bj * 128);
                    const f32x4 a0 = acc[ai][bj][m][0], a1 = acc[ai][bj][m][1];
                    u32x4 w; w.x = cvt_pk_bf16(bf_lo(o.x) + a0[0], bf_hi(o.x) + a0[1]); w.y = cvt_pk_bf16(bf_lo(o.y) + a0[2], bf_hi(o.y) + a0[3]);
                    w.z = cvt_pk_bf16(bf_lo(o.z) + a1[0], bf_hi(o.z) + a1[1]); w.w = cvt_pk_bf16(bf_lo(o.w) + a1[2], bf_hi(o.w) + a1[3]);
                    *(u32x4*)(rowp + bj * 128) = w;
                }
            }
    }
};
struct EpiMoe1 {
    bf16_t* HID; const float* RS; const float* WT;
    __device__ __forceinline__ void operator()(const f32x4 (&acc)[2][2][4][2], const pg8::Unit& u, int wr, int wc, int fr, int fq) const {
        const int lr0 = wr * 64 + fr, col0 = u.pn * 128 + wc * 32 + 8 * fq;
#pragma unroll
        for (int ai = 0; ai < 2; ++ai)
#pragma unroll
            for (int m = 0; m < 4; ++m) {
                const int lr = lr0 + ai * 128 + m * 16; const bool ok = lr < u.nvalid;
                const float rs = ok ? RS[u.lbase + lr] : 0.f, wt = ok ? WT[u.lbase + lr] : 0.f;
                float v[8];
#pragma unroll
                for (int j = 0; j < 8; ++j) { const float g = acc[ai][0][m][j >> 2][j & 3] * rs, up = acc[ai][1][m][j >> 2][j & 3] * rs; v[j] = silu_f(g) * up * wt; }
                u32x4 w; w.x = cvt_pk_bf16(v[0], v[1]); w.y = cvt_pk_bf16(v[2], v[3]); w.z = cvt_pk_bf16(v[4], v[5]); w.w = cvt_pk_bf16(v[6], v[7]);
                *(u32x4*)(HID + (size_t)(u.pm * 256 + lr) * DEXP + col0) = w;
            }
    }
};
struct EpiMoe2 {
    bf16_t* EO;
    __device__ __forceinline__ void operator()(const f32x4 (&acc)[2][2][4][2], const pg8::Unit& u, int wr, int wc, int fr, int fq) const {
        const int lr0 = wr * 64 + fr, col0 = u.pn * 256 + wc * 32 + 8 * fq;
#pragma unroll
        for (int ai = 0; ai < 2; ++ai)
#pragma unroll
            for (int m = 0; m < 4; ++m) {
                const int lr = lr0 + ai * 128 + m * 16;
                if (lr < u.nvalid) {
                    bf16_t* rowp = EO + (size_t)(u.pm * 256 + lr) * D + col0;
#pragma unroll
                    for (int bj = 0; bj < 2; ++bj) {
                        const f32x4 a0 = acc[ai][bj][m][0], a1 = acc[ai][bj][m][1];
                        u32x4 w; w.x = cvt_pk_bf16(a0[0], a0[1]); w.y = cvt_pk_bf16(a0[2], a0[3]); w.z = cvt_pk_bf16(a1[0], a1[1]); w.w = cvt_pk_bf16(a1[2], a1[3]);
                        *(u32x4*)(rowp + bj * 128) = w;
                    }
                }
            }
    }
};

struct MoeOrder {
    const LAS int* pre; const LAS int* cnt; const char* Abase; const char* Bbase; int c0, ncls, nsub, G, blk; size_t a_tile_bytes, b_exp_bytes, b_sub_bytes; bool gather;
    __device__ bool next(int i, pg8::Unit& u) const {
        const int L = i * G + blk; const int t0 = pre[c0], t1 = pre[c0 + ncls];
        if ((gather && i >= 4) || L >= (t1 - t0) * nsub) return false;
        const int ti = t0 + L / nsub, sub = L % nsub;
        int c = c0, hi_ = c0 + ncls; while (hi_ - c > 1) { const int mid = (c + hi_) >> 1; if (pre[mid] <= ti) c = mid; else hi_ = mid; }
        const int j0 = (ti - pre[c]) * 256, e = c & 31;
        u.pm = ti; u.pn = sub; u.nvalid = min(256, cnt[c] - j0); u.lbase = c * LISTCAP + j0; u.slot = i; u.fin = 1;
        u.A = gather ? Abase : Abase + (size_t)ti * a_tile_bytes;
        u.B = Bbase + (size_t)e * b_exp_bytes + (size_t)sub * b_sub_bytes;
        return true;
    }
};

__device__ __forceinline__ void transpose_item(const float* W, int ldw, int k0, int n0, const float* gain, bf16_t* WT, int Kd, int drow0, LAS float* scr, int lane) {
#pragma unroll 8
    for (int i = 0; i < 32; ++i) { const int kk = 2 * i + (lane >> 5); float w = W[(size_t)(k0 + kk) * ldw + n0 + (lane & 31)]; if (gain) w *= gain[k0 + kk]; scr[kk * 33 + (lane & 31)] = w; }
    asm volatile("s_waitcnt lgkmcnt(0)" ::: "memory");
    const int c = lane & 7;
#pragma unroll
    for (int j = 0; j < 4; ++j) { const int n = (lane >> 3) + 8 * j; const LAS float* s = scr + (8 * c) * 33 + n;
        u32x4 o; o.x = cvt_pk_bf16(s[0 * 33], s[1 * 33]); o.y = cvt_pk_bf16(s[2 * 33], s[3 * 33]); o.z = cvt_pk_bf16(s[4 * 33], s[5 * 33]); o.w = cvt_pk_bf16(s[6 * 33], s[7 * 33]);
        *(u32x4*)(WT + (size_t)(drow0 + n) * Kd + k0 + 8 * c) = o; }
    asm volatile("s_waitcnt lgkmcnt(0)" ::: "memory");
}

__device__ __forceinline__ void conv_item(const float* W, int ldw, int k0, int nit, int n0, const float* gain, bf16_t* WT, int Kd, int drow0, int mode, int lane) {
    const int nl = 4 * lane;
    int dr = mode == 0 ? drow0 + nl : ((nl >> 7) * 256 + (mode - 1) * 128 + (nl & 127));
    if (mode == 3) { const int n = n0 + nl;
        dr = n; if (n < 2048) { const int seg = n >> 9, hh = (n >> 7) & 3, k = n & 127; dr = (4 * (seg >> 1) + hh) * 256 + (seg & 1) * 128 + k; } }
    const float* src = W + (size_t)k0 * ldw + n0 + nl;
    bf16_t* dst = WT + (size_t)dr * Kd + k0;
    for (int it = 0; it < nit; ++it) {
        f32x4 v[8];
#pragma unroll
        for (int j = 0; j < 8; ++j) v[j] = *(const f32x4*)(src + (size_t)(8 * it + j) * ldw);
        if (gain) {
#pragma unroll
            for (int j = 0; j < 8; ++j) v[j] = v[j] * gain[k0 + 8 * it + j];
        }
#pragma unroll
        for (int nn = 0; nn < 4; ++nn) {
            u32x4 o; o.x = cvt_pk_bf16(v[0][nn], v[1][nn]); o.y = cvt_pk_bf16(v[2][nn], v[3][nn]); o.z = cvt_pk_bf16(v[4][nn], v[5][nn]); o.w = cvt_pk_bf16(v[6][nn], v[7][nn]);
            *(u32x4*)(dst + (size_t)nn * Kd + 8 * it) = o;
        }
    }
}
__device__ __forceinline__ void conv_tile64(const float* W, int ldw, int k0, int n0, const float* gain, bf16_t* WT, int Kd, int drow0, int lane) {
    const int n4 = lane & 15, kq = lane >> 4;
    const float* src = W + (size_t)(k0 + 16 * kq) * ldw + n0 + 4 * n4;
    f32x4 v[16];
#pragma unroll
    for (int j = 0; j < 16; ++j) v[j] = *(const f32x4*)(src + (size_t)j * ldw);
    if (gain) {
        const f32x4* gp = (const f32x4*)(gain + k0 + 16 * kq);
#pragma unroll
        for (int j4 = 0; j4 < 4; ++j4) { const f32x4 g = gp[j4];
#pragma unroll
            for (int jj = 0; jj < 4; ++jj) v[4 * j4 + jj] = v[4 * j4 + jj] * g[jj]; }
    }
    bf16_t* dst = WT + (size_t)(drow0 + 4 * n4) * Kd + k0 + 16 * kq;
#pragma unroll
    for (int nn = 0; nn < 4; ++nn)
#pragma unroll
        for (int hf = 0; hf < 2; ++hf) {
            u32x4 o; o.x = cvt_pk_bf16(v[8 * hf][nn], v[8 * hf + 1][nn]); o.y = cvt_pk_bf16(v[8 * hf + 2][nn], v[8 * hf + 3][nn]); o.z = cvt_pk_bf16(v[8 * hf + 4][nn], v[8 * hf + 5][nn]); o.w = cvt_pk_bf16(v[8 * hf + 6][nn], v[8 * hf + 7][nn]);
            *(u32x4*)(dst + (size_t)nn * Kd + 8 * hf) = o;
        }
}
__device__ __forceinline__ void conv_expert_weights(const float* w_gate, const float* w_up, const float* w_down, const float* gain, bf16_t* W13l, bf16_t* WDl, int w0, int nw, int lane, int iend = 6144) {
    if (iend > 6144) iend = 6144;
    for (int it = w0; it < iend; it += nw) {
        if (it < 4096) { const int up = it >> 11, r = it & 2047, e = r >> 6, kb = (r >> 2) & 15, nb = r & 3; const int n0 = nb * 64;
            conv_tile64((up ? w_up : w_gate) + (size_t)e * D * DEXP, DEXP, kb * 64, n0, gain, W13l + (size_t)e * 512 * D, D, (n0 >> 7) * 256 + up * 128 + (n0 & 127), lane); }
        else { const int r = it - 4096, e = r >> 6, kb = (r >> 4) & 3, nb = r & 15;
            conv_tile64(w_down + (size_t)e * DEXP * D, D, kb * 64, nb * 64, nullptr, WDl + (size_t)e * D * DEXP, DEXP, nb * 64, lane); }
    }
}

constexpr int HP = 144, HP2 = 72;
constexpr int H_QT = 0, H_KT = 18432, H_V = 36864, H_ST = 55296, H_AT = 92160, H_C = 101376, H_NRM = 103424;
typedef short s16x4 __attribute__((ext_vector_type(4)));
#define LBAR() do { asm volatile("s_waitcnt lgkmcnt(0)" ::: "memory"); __builtin_amdgcn_s_barrier(); asm volatile("" ::: "memory"); } while (0)
__device__ __forceinline__ bf16x8 ldsfrag(const LAS bf16_t* base, int row, int pitch, int kofs) { return *(const LAS bf16x8*)(base + row * pitch + kofs); }
__device__ __forceinline__ bf16x8 trfrag(const LAS bf16_t* img, int pitch, int ks, int cb, int lane) {
    const int g = lane >> 4, q = (lane & 15) >> 2, p = lane & 3;
    const LAS bf16_t* a0 = img + (32 * ks + 8 * g + q) * pitch + 16 * cb + 4 * p;
    const s16x4 lo = __builtin_bit_cast(s16x4, __builtin_amdgcn_ds_read_tr16_b64_v4i16((LAS s16x4*)a0));
    const s16x4 hi = __builtin_bit_cast(s16x4, __builtin_amdgcn_ds_read_tr16_b64_v4i16((LAS s16x4*)(a0 + 4 * pitch)));
    return (bf16x8){lo[0], lo[1], lo[2], lo[3], hi[0], hi[1], hi[2], hi[3]};
}

constexpr int H_GI = 104448, H_OI = 122880;

__device__ __forceinline__ void hgrn_pass1(LAS unsigned char* lds, const bf16_t* QTg, const bf16_t* KTg, const bf16_t* VHg, const bf16_t* GHg, const float* EBg, const float* ERg, const float* EKg,
                                           bf16_t* OL, float* SL, float* DL, bf16_t* Y, const float* gnorm, int b, int h, int seg) {
    const int tid = otid(), wave = __builtin_amdgcn_readfirstlane(tid >> 6), lane = tid & 63, fr = lane & 15, fq = lane >> 4;
    LAS bf16_t* QT = (LAS bf16_t*)(lds + H_QT); LAS bf16_t* KT = (LAS bf16_t*)(lds + H_KT); LAS bf16_t* VI = (LAS bf16_t*)(lds + H_V); LAS bf16_t* ST = (LAS bf16_t*)(lds + H_ST);
    LAS bf16_t* AT = (LAS bf16_t*)(lds + H_AT); LAS float* CS = (LAS float*)(lds + H_C); LAS float* NRM = (LAS float*)(lds + H_NRM);
    LAS bf16_t* GI = (LAS bf16_t*)(lds + H_GI); LAS bf16_t* OI = (LAS bf16_t*)(lds + H_OI);
    f32x4 S[2][4];
#pragma unroll
    for (int i = 0; i < 2; ++i)
#pragma unroll
        for (int j = 0; j < 4; ++j) S[i][j] = (f32x4){0.f, 0.f, 0.f, 0.f};
    const int kq = wave >> 1, vh = wave & 1;
    const int th = wave >> 2, vq = wave & 3;
    for (int i = tid; i < 128 * HP / 2; i += 512) ((LAS unsigned*)ST)[i] = 0u;
    const size_t rowbase = (size_t)b * SEQ;
    const int hc = h * 128;
    const int prow = tid >> 4, pch = tid & 15;
    u32x4 tq[2], tk[2], tv[2], tg[2]; float cst = 0.f;
    const int csel = tid >> 7, ck = tid & 127;
    const int c0 = seg * 8, c1 = c0 + 8; float dk = 1.0f;
    const bool fin = (seg == 0);
#define HG_LOAD(c) do { const size_t o_ = TILE_OFF(h, rowbase + (size_t)(c) * 64) + (size_t)tid * 8; \
        _Pragma("unroll") for (int i_ = 0; i_ < 2; ++i_) { tq[i_] = *(const u32x4*)(QTg + o_ + 4096 * i_); tk[i_] = *(const u32x4*)(KTg + o_ + 4096 * i_); tv[i_] = *(const u32x4*)(VHg + o_ + 4096 * i_); \
            if (fin) tg[i_] = *(const u32x4*)(GHg + o_ + 4096 * i_); } \
        { const size_t cg_ = (rowbase >> 6) + (c); if (csel == 0) cst = EBg[cg_ * 512 + hc + ck]; else if (csel == 1) cst = EKg[cg_ * 512 + hc + ck]; else if (csel == 2 && (c) + 1 < c1) cst = ERg[(cg_ + 1) * 512 + hc + ck]; } } while (0)
    HG_LOAD(c0);
    for (int c = c0; c < c1; ++c) {
#pragma unroll
        for (int i = 0; i < 2; ++i) { const int o = (prow + 32 * i) * HP + pch * 8; *(LAS u32x4*)(QT + o) = tq[i]; *(LAS u32x4*)(KT + o) = tk[i]; *(LAS u32x4*)(VI + o) = tv[i]; if (fin) *(LAS u32x4*)(GI + o) = tg[i]; }
        if (tid < 384) CS[tid] = cst;
        if (c + 1 < c1) HG_LOAD(c + 1);
        const int tb = wave >> 1, wh = wave & 1, trow = tb * 16 + fr;
        LBAR();
        if (tid < 128) dk *= CS[tid];
        bf16x8 qf[4];
#pragma unroll
        for (int ks = 0; ks < 4; ++ks) qf[ks] = ldsfrag(QT, trow, HP, ks * 32 + fq * 8);
#pragma unroll
        for (int x = 0; x < 2; ++x) {
            const int sb = 2 * wh + x; f32x4 a = (f32x4){0.f, 0.f, 0.f, 0.f};
            if (sb <= tb) {
#pragma unroll
                for (int ks = 0; ks < 4; ++ks) a = __builtin_amdgcn_mfma_f32_16x16x32_bf16(ldsfrag(KT, sb * 16 + fr, HP, ks * 32 + fq * 8), qf[ks], a, 0, 0, 0);
            }
            const int s0 = sb * 16 + 4 * fq; float v[4];
#pragma unroll
            for (int i = 0; i < 4; ++i) v[i] = (sb <= tb && s0 + i <= trow) ? a[i] : 0.f;
            *(LAS u32x2*)(AT + trow * HP2 + s0) = (u32x2){cvt_pk_bf16(v[0], v[1]), cvt_pk_bf16(v[2], v[3])};
        }
        {
            bf16x8 kf[2][2];
#pragma unroll
            for (int i = 0; i < 2; ++i)
#pragma unroll
                for (int ks = 0; ks < 2; ++ks) kf[i][ks] = trfrag(KT, HP, ks, 2 * kq + i, lane);
            f32x4 eb[2], ek[2];
#pragma unroll
            for (int i = 0; i < 2; ++i) { eb[i] = *(const LAS f32x4*)(CS + (2 * kq + i) * 16 + 4 * fq); ek[i] = *(const LAS f32x4*)(CS + 128 + (2 * kq + i) * 16 + 4 * fq); }
#pragma unroll
            for (int j = 0; j < 4; ++j) {
                bf16x8 vf[2];
#pragma unroll
                for (int ks = 0; ks < 2; ++ks) vf[ks] = trfrag(VI, HP, ks, 4 * vh + j, lane);
#pragma unroll
                for (int i = 0; i < 2; ++i) { f32x4 p = (f32x4){0.f, 0.f, 0.f, 0.f};
#pragma unroll
                    for (int ks = 0; ks < 2; ++ks) p = __builtin_amdgcn_mfma_f32_16x16x32_bf16(kf[i][ks], vf[ks], p, 0, 0, 0);
                    S[i][j] = S[i][j] * eb[i] + p * ek[i]; }
            }
        }
        LBAR();
        f32x4 o[2][2];
        {
            bf16x8 q2[2][4], af[2][2];
#pragma unroll
            for (int i = 0; i < 2; ++i) {
#pragma unroll
                for (int ks = 0; ks < 4; ++ks) q2[i][ks] = ldsfrag(QT, (2 * th + i) * 16 + fr, HP, ks * 32 + fq * 8);
#pragma unroll
                for (int ks = 0; ks < 2; ++ks) af[i][ks] = ldsfrag(AT, (2 * th + i) * 16 + fr, HP2, ks * 32 + fq * 8); }
#pragma unroll
            for (int j = 0; j < 2; ++j) { const int vb = 2 * vq + j;
                bf16x8 sf[4], vf[2];
#pragma unroll
                for (int ks = 0; ks < 4; ++ks) sf[ks] = ldsfrag(ST, vb * 16 + fr, HP, ks * 32 + fq * 8);
#pragma unroll
                for (int ks = 0; ks < 2; ++ks) vf[ks] = trfrag(VI, HP, ks, vb, lane);
#pragma unroll
                for (int i = 0; i < 2; ++i) { f32x4 a = (f32x4){0.f, 0.f, 0.f, 0.f};
#pragma unroll
                    for (int ks = 0; ks < 4; ++ks) a = __builtin_amdgcn_mfma_f32_16x16x32_bf16(sf[ks], q2[i][ks], a, 0, 0, 0);
#pragma unroll
                    for (int ks = 0; ks < 2; ++ks) a = __builtin_amdgcn_mfma_f32_16x16x32_bf16(vf[ks], af[i][ks], a, 0, 0, 0);
                    o[i][j] = a; }
            }
        }
        if (fin) {
#pragma unroll
            for (int i = 0; i < 2; ++i) { float ss = 0.f;
#pragma unroll
                for (int j = 0; j < 2; ++j) ss += (o[i][j][0] * o[i][j][0] + o[i][j][1] * o[i][j][1]) + (o[i][j][2] * o[i][j][2] + o[i][j][3] * o[i][j][3]);
                ss += __shfl_xor(ss, 16); ss += __shfl_xor(ss, 32);
                if (fq == 0) NRM[((2 * th + i) * 16 + fr) * 4 + vq] = ss; }
        }
        LBAR();
#pragma unroll
        for (int i = 0; i < 2; ++i) { const int t = (2 * th + i) * 16 + fr;
            float rstd = 1.0f;
            if (fin) { const f32x4 nr = *(const LAS f32x4*)(NRM + t * 4); rstd = 1.0f / sqrtf(((nr[0] + nr[1]) + (nr[2] + nr[3])) * (1.0f / 128.0f) + RMS_EPS); }
#pragma unroll
            for (int j = 0; j < 2; ++j) { const int v0 = (2 * vq + j) * 16 + 4 * fq;
                if (fin) { const f32x4 gn = *(const f32x4*)(gnorm + v0); const u32x2 gq = *(const LAS u32x2*)(GI + t * HP + v0);
                    const float y0 = o[i][j][0] * rstd * gn[0] * bf_lo(gq.x), y1 = o[i][j][1] * rstd * gn[1] * bf_hi(gq.x), y2 = o[i][j][2] * rstd * gn[2] * bf_lo(gq.y), y3 = o[i][j][3] * rstd * gn[3] * bf_hi(gq.y);
                    *(LAS u32x2*)(OI + t * HP + v0) = (u32x2){cvt_pk_bf16(y0, y1), cvt_pk_bf16(y2, y3)}; }
                else *(LAS u32x2*)(OI + t * HP + v0) = (u32x2){cvt_pk_bf16(o[i][j][0], o[i][j][1]), cvt_pk_bf16(o[i][j][2], o[i][j][3])}; }
        }
#pragma unroll
        for (int i = 0; i < 2; ++i) { const f32x4 er = *(const LAS f32x4*)(CS + 256 + (2 * kq + i) * 16 + 4 * fq);
#pragma unroll
            for (int j = 0; j < 4; ++j) { const f32x4 sv = S[i][j] * er;
                *(LAS u32x2*)(ST + ((4 * vh + j) * 16 + fr) * HP + (2 * kq + i) * 16 + 4 * fq) = (u32x2){cvt_pk_bf16(sv[0], sv[1]), cvt_pk_bf16(sv[2], sv[3])}; } }
        LBAR();
#pragma unroll
        for (int i = 0; i < 2; ++i) { const int r = prow + 32 * i; const u32x4 w = *(const LAS u32x4*)(OI + r * HP + pch * 8);
            if (fin) *(u32x4*)(Y + (rowbase + c * 64 + r) * D + hc + pch * 8) = w; else *(u32x4*)(OL + TILE_OFF(h, rowbase + c * 64 + r) + pch * 8) = w; }
    }
#undef HG_LOAD
    const int uu = (b * 4 + h) * 4 + seg;
#pragma unroll
    for (int i = 0; i < 2; ++i)
#pragma unroll
        for (int j = 0; j < 4; ++j) *(f32x4*)(SL + (size_t)uu * 16384 + ((4 * vh + j) * 16 + fr) * 128 + (2 * kq + i) * 16 + 4 * fq) = S[i][j];
    if (tid < 128) DL[uu * 128 + tid] = dk;
    LBAR();
}

__device__ __forceinline__ void hgrn_pass2(LAS unsigned char* lds, const bf16_t* QTg, const bf16_t* GHg, const float* EBg, const float* ERg, const bf16_t* OL, const float* SL, const float* DL,
                                           bf16_t* Y, const float* gnorm, int b, int h, int seg) {
    const int tid = otid(), wave = __builtin_amdgcn_readfirstlane(tid >> 6), lane = tid & 63, fr = lane & 15, fq = lane >> 4;
    LAS bf16_t* QT = (LAS bf16_t*)(lds + H_QT); LAS bf16_t* LI = (LAS bf16_t*)(lds + H_KT); LAS bf16_t* GI = (LAS bf16_t*)(lds + H_GI); LAS bf16_t* OI = (LAS bf16_t*)(lds + H_OI);
    LAS bf16_t* ST = (LAS bf16_t*)(lds + H_ST); LAS float* CS = (LAS float*)(lds + H_C); LAS float* NRM = (LAS float*)(lds + H_NRM);
    const size_t rowbase = (size_t)b * SEQ; const int hc = h * 128, c0 = seg * 8, c1 = c0 + 8, uu0 = (b * 4 + h) * 4;
    f32x4 S[8];
#pragma unroll
    for (int kb = 0; kb < 8; ++kb) S[kb] = (f32x4){0.f, 0.f, 0.f, 0.f};
    for (int j = 0; j < seg; ++j) {
#pragma unroll
        for (int kb = 0; kb < 8; ++kb) { const f32x4 dj = *(const f32x4*)(DL + (uu0 + j) * 128 + kb * 16 + 4 * fq), lj = *(const f32x4*)(SL + (size_t)(uu0 + j) * 16384 + (wave * 16 + fr) * 128 + kb * 16 + 4 * fq);
            S[kb] = S[kb] * dj + lj; }
    }
    const int tb = wave >> 1, wh = wave & 1, trow = tb * 16 + fr;
    const int csel = tid >> 7, ck = tid & 127, prow = tid >> 4, pch = tid & 15;
    const size_t cgb = rowbase >> 6;
    { const f32x4* erp = (const f32x4*)(ERg + (cgb + c0) * 512 + hc);
#pragma unroll
      for (int kb = 0; kb < 8; ++kb) { const f32x4 er = erp[kb * 4 + fq]; const f32x4 sv = S[kb] * er;
          *(LAS u32x2*)(ST + (wave * 16 + fr) * HP + kb * 16 + 4 * fq) = (u32x2){cvt_pk_bf16(sv[0], sv[1]), cvt_pk_bf16(sv[2], sv[3])}; } }
    if (tid < 256) CS[(c0 & 1) * 256 + tid] = csel == 0 ? EBg[(cgb + c0) * 512 + hc + ck] : ERg[(cgb + c0 + 1) * 512 + hc + ck];
    u32x4 tq[2], tl[2], tg[2];
#define P2_LOAD(c) do { const size_t o_ = TILE_OFF(h, rowbase + (size_t)(c) * 64) + (size_t)tid * 8; _Pragma("unroll") for (int i_ = 0; i_ < 2; ++i_) { \
        tq[i_] = *(const u32x4*)(QTg + o_ + 4096 * i_); tl[i_] = *(const u32x4*)(OL + o_ + 4096 * i_); tg[i_] = *(const u32x4*)(GHg + o_ + 4096 * i_); } } while (0)
    P2_LOAD(c0);
    for (int c = c0; c < c1; ++c) {
#pragma unroll
        for (int i = 0; i < 2; ++i) { const int o = (prow + 32 * i) * HP + pch * 8; *(LAS u32x4*)(QT + o) = tq[i]; *(LAS u32x4*)(LI + o) = tl[i]; *(LAS u32x4*)(GI + o) = tg[i]; }
        float cnext = 0.f;
        if (c + 1 < c1) {
            P2_LOAD(c + 1);
            if (tid < 256) cnext = csel == 0 ? EBg[(cgb + c + 1) * 512 + hc + ck] : (c + 2 < c1 ? ERg[(cgb + c + 2) * 512 + hc + ck] : 0.f);
        }
        LBAR();
        f32x4 o[4];
        {
            bf16x8 qf[4];
#pragma unroll
            for (int ks = 0; ks < 4; ++ks) qf[ks] = ldsfrag(QT, trow, HP, ks * 32 + fq * 8);
#pragma unroll
            for (int x = 0; x < 4; ++x) { const int vb = 4 * wh + x; const u32x2 ol = *(const LAS u32x2*)(LI + trow * HP + vb * 16 + 4 * fq);
                f32x4 a = (f32x4){bf_lo(ol.x), bf_hi(ol.x), bf_lo(ol.y), bf_hi(ol.y)};
#pragma unroll
                for (int ks = 0; ks < 4; ++ks) a = __builtin_amdgcn_mfma_f32_16x16x32_bf16(ldsfrag(ST, vb * 16 + fr, HP, ks * 32 + fq * 8), qf[ks], a, 0, 0, 0);
                o[x] = a; }
        }
        float ss = 0.f;
#pragma unroll
        for (int x = 0; x < 4; ++x) ss += (o[x][0] * o[x][0] + o[x][1] * o[x][1]) + (o[x][2] * o[x][2] + o[x][3] * o[x][3]);
        ss += __shfl_xor(ss, 16); ss += __shfl_xor(ss, 32);
        if (fq == 0) NRM[trow * 2 + wh] = ss;
        LBAR();
        {
            const float tot = NRM[trow * 2] + NRM[trow * 2 + 1];
            const float rstd = 1.0f / sqrtf(tot * (1.0f / 128.0f) + RMS_EPS);
#pragma unroll
            for (int x = 0; x < 4; ++x) { const int v0 = (4 * wh + x) * 16 + 4 * fq; const f32x4 gn = *(const f32x4*)(gnorm + v0); const u32x2 gq = *(const LAS u32x2*)(GI + trow * HP + v0);
                const float y0 = o[x][0] * rstd * gn[0] * bf_lo(gq.x), y1 = o[x][1] * rstd * gn[1] * bf_hi(gq.x), y2 = o[x][2] * rstd * gn[2] * bf_lo(gq.y), y3 = o[x][3] * rstd * gn[3] * bf_hi(gq.y);
                *(LAS u32x2*)(OI + trow * HP + v0) = (u32x2){cvt_pk_bf16(y0, y1), cvt_pk_bf16(y2, y3)}; }
        }
        if (c + 1 < c1) {
            const LAS float* cs = CS + (c & 1) * 256;
#pragma unroll
            for (int kb = 0; kb < 8; ++kb) { const f32x4 eb = *(const LAS f32x4*)(cs + kb * 16 + 4 * fq), er = *(const LAS f32x4*)(cs + 128 + kb * 16 + 4 * fq);
                S[kb] = S[kb] * eb; const f32x4 sv = S[kb] * er;
                *(LAS u32x2*)(ST + (wave * 16 + fr) * HP + kb * 16 + 4 * fq) = (u32x2){cvt_pk_bf16(sv[0], sv[1]), cvt_pk_bf16(sv[2], sv[3])}; }
            if (tid < 256) CS[((c + 1) & 1) * 256 + tid] = cnext;
        }
        LBAR();
#pragma unroll
        for (int i = 0; i < 2; ++i) { const int r = prow + 32 * i; *(u32x4*)(Y + (rowbase + c * 64 + r) * D + hc + pch * 8) = *(const LAS u32x4*)(OI + r * HP + pch * 8); }
    }
    LBAR();
#undef P2_LOAD
}

constexpr int T_WL = 0, T_VN = 36864, T_UI = 73728, T_LNC = 110592;
__device__ __forceinline__ void tmlp_units(LAS unsigned char* lds, const bf16_t* UU, const bf16_t* VV, bf16_t* Y, const bf16_t* Wsp, const float* lng, const float* lnb, const float* bsp, int i0, int i1, int st) {
    const int tid = otid(), wave = __builtin_amdgcn_readfirstlane(tid >> 6), lane = tid & 63, fr = lane & 15, fq = lane >> 4;
    LAS bf16_t* WL = (LAS bf16_t*)(lds + T_WL); LAS bf16_t* VN = (LAS bf16_t*)(lds + T_VN); LAS bf16_t* UI = (LAS bf16_t*)(lds + T_UI); LAS float* LNC = (LAS float*)(lds + T_LNC);
    if (i0 >= i1) return;
    const int s = tid >> 2, qd = tid & 3, c0 = wave * 16 + 4 * fq;
    u32x4 tu[4], tv[4];
#define TM_LOAD(i_) do { const int g_ = (i_) >> 8, bn_ = (i_) & 255; const size_t r_ = (size_t)(bn_ >> 4) * SEQ + (bn_ & 15) * 128; const bf16_t* up_ = UU + TILE_OFF(g_, r_) + (size_t)tid * 8; \
        const bf16_t* vp_ = VV + TILE_OFF(g_, r_ + s) + qd * 32; _Pragma("unroll") for (int j_ = 0; j_ < 4; ++j_) { tu[j_] = *(const u32x4*)(up_ + 4096 * j_); tv[j_] = *(const u32x4*)(vp_ + 8 * j_); } } while (0)
    TM_LOAD(i0);
    int gcur = -1;
    for (int i = i0; i < i1; i += st) {
        const int g = i >> 8, bn = i & 255; const size_t r0 = (size_t)(bn >> 4) * SEQ + (bn & 15) * 128;
        if (g != gcur) {
            const bf16_t* wg = Wsp + (size_t)g * 128 * 128;
#pragma unroll
            for (int j = 0; j < 4; ++j) { const int p = tid + 512 * j; *(LAS u32x4*)(WL + (p >> 4) * HP + (p & 15) * 8) = *(const u32x4*)(wg + (p >> 4) * 128 + (p & 15) * 8); }
            if (tid < 384) LNC[tid] = (tid < 128 ? lng : tid < 256 ? lnb : bsp)[g * 128 + (tid & 127)];
            gcur = g;
            LBAR();
        }
        {
            float v[32];
#pragma unroll
            for (int j = 0; j < 4; ++j) { const u32x4 w = tv[j]; v[8 * j] = bf_lo(w.x); v[8 * j + 1] = bf_hi(w.x); v[8 * j + 2] = bf_lo(w.y); v[8 * j + 3] = bf_hi(w.y); v[8 * j + 4] = bf_lo(w.z); v[8 * j + 5] = bf_hi(w.z); v[8 * j + 6] = bf_lo(w.w); v[8 * j + 7] = bf_hi(w.w); }
#pragma unroll
            for (int j = 0; j < 4; ++j) { const int p = tid + 512 * j; *(LAS u32x4*)(UI + (p >> 4) * HP + (p & 15) * 8) = tu[j]; }
            if (i + st < i1) TM_LOAD(i + st);
            float sm = 0.f;
#pragma unroll
            for (int j = 0; j < 32; ++j) sm += v[j];
            sm += __shfl_xor(sm, 1); sm += __shfl_xor(sm, 2);
            const float mu = sm * (1.0f / 128.0f); float sq = 0.f;
#pragma unroll
            for (int j = 0; j < 32; ++j) { v[j] -= mu; sq += v[j] * v[j]; }
            sq += __shfl_xor(sq, 1); sq += __shfl_xor(sq, 2);
            const float rstd = 1.0f / sqrtf(sq * (1.0f / 128.0f) + LN_EPS);
            const LAS f32x4* gp = (const LAS f32x4*)(LNC + qd * 32); const LAS f32x4* bp = (const LAS f32x4*)(LNC + 128 + qd * 32);
#pragma unroll
            for (int j = 0; j < 4; ++j) { const f32x4 g0 = gp[2 * j], g1 = gp[2 * j + 1], b0 = bp[2 * j], b1 = bp[2 * j + 1];
                u32x4 w; w.x = cvt_pk_bf16(v[8 * j] * rstd * g0[0] + b0[0], v[8 * j + 1] * rstd * g0[1] + b0[1]); w.y = cvt_pk_bf16(v[8 * j + 2] * rstd * g0[2] + b0[2], v[8 * j + 3] * rstd * g0[3] + b0[3]);
                w.z = cvt_pk_bf16(v[8 * j + 4] * rstd * g1[0] + b1[0], v[8 * j + 5] * rstd * g1[1] + b1[1]); w.w = cvt_pk_bf16(v[8 * j + 6] * rstd * g1[2] + b1[2], v[8 * j + 7] * rstd * g1[3] + b1[3]);
                *(LAS u32x4*)(VN + s * HP + qd * 32 + 8 * j) = w; }
        }
        LBAR();
        bf16x8 vf[4];
#pragma unroll
        for (int ks = 0; ks < 4; ++ks) vf[ks] = trfrag(VN, HP, ks, wave, lane);
#pragma unroll
        for (int tb = 0; tb < 8; ++tb) {
            f32x4 a = (f32x4){0.f, 0.f, 0.f, 0.f};
#pragma unroll
            for (int ks = 0; ks < 4; ++ks) if (ks <= (tb >> 1)) a = __builtin_amdgcn_mfma_f32_16x16x32_bf16(vf[ks], ldsfrag(WL, tb * 16 + fr, HP, ks * 32 + fq * 8), a, 0, 0, 0);
            LAS u32x2* up = (LAS u32x2*)(UI + (tb * 16 + fr) * HP + c0); const u32x2 uu = *up; const float bias = LNC[256 + tb * 16 + fr];
            const float y0 = bf_lo(uu.x) * (a[0] + bias), y1 = bf_hi(uu.x) * (a[1] + bias), y2 = bf_lo(uu.y) * (a[2] + bias), y3 = bf_hi(uu.y) * (a[3] + bias);
            *up = (u32x2){cvt_pk_bf16(y0, y1), cvt_pk_bf16(y2, y3)};
        }
        LBAR();
#pragma unroll
        for (int j = 0; j < 4; ++j) { const int p = tid + 512 * j, r = p >> 4, ch = p & 15; *(u32x4*)(Y + (r0 + r) * D + 512 + g * 128 + ch * 8) = *(const LAS u32x4*)(UI + r * HP + ch * 8); }
        LBAR();
    }
#undef TM_LOAD
}
constexpr int NPHASE = 18;
typedef __attribute__((address_space(4))) const Args CArgs;
__device__ __forceinline__ CArgs* kargs() { CArgs* p = (CArgs*)__builtin_amdgcn_kernarg_segment_ptr(); asm volatile("" : "+s"(p)); return p; }
#define WSP_(T, off) ((T*)(ws + (off)))

__device__ __forceinline__ void grid_seam(LAS unsigned char* lds) {
    CArgs* ap = kargs();
    XcdBarrier b; b.bar = (unsigned*)(ap->ws + WS_CTL) + CW_BAR; b.x = xb_xcc_id(); b.st = (volatile LAS unsigned*)(lds + MISC_OFF) + 8;
    xcd_barrier(b);
}

__device__ __forceinline__ void phase_prologue(LAS unsigned char* lds) {
    CArgs* ap = kargs(); unsigned char* ws = ap->ws;
    const int tid = otid(), lane = tid & 63, wave = __builtin_amdgcn_readfirstlane(tid >> 6), G = gridDim.x, blk = blockIdx.x;
    const int gw = blk * 8 + wave, NGW = G * 8;
    bf16_t* WIN = WSP_(bf16_t, WS_WIN); bf16_t* WOUT = WSP_(bf16_t, WS_WOUT); bf16_t* W13 = WSP_(bf16_t, WS_W13); bf16_t* WD = WSP_(bf16_t, WS_WD);
    bf16_t* WR = WSP_(bf16_t, WS_WR); bf16_t* WSP = WSP_(bf16_t, WS_WSP); float* RSTD1 = WSP_(float, WS_RSTD1); bf16_t* XSA = WSP_(bf16_t, WS_XSA);
    constexpr int I_IN = 16 * 48, I_OUT = 16 * 16;
    for (int it = gw; it < NLAYER * (I_IN + I_OUT); it += NGW) {
        const int l = it / (I_IN + I_OUT), r = it % (I_IN + I_OUT);
        if (r < I_IN) { const int kb = r / 48, nb = r % 48, n0 = nb * 64; int dr = n0;
            if (n0 < 2048) { const int seg = n0 >> 9, hh = (n0 >> 7) & 3, k = n0 & 127; dr = (4 * (seg >> 1) + hh) * 256 + (seg & 1) * 128 + k; }
            conv_tile64(ap->w_in + (size_t)l * D * DIN, DIN, kb * 64, n0, ap->norm_mix + l * D, WIN + (size_t)l * DIN * D, D, dr, lane); }
        else { const int q = r - I_IN, kb = q / 16, nb = q % 16; conv_tile64(ap->w_out + (size_t)l * D * D, D, kb * 64, nb * 64, nullptr, WOUT + (size_t)l * D * D, D, nb * 64, lane); }
    }
    for (int i = blk * 512 + tid; i < NLAYER * 48 * D; i += G * 512) { const int l = i / (48 * D), q = i % (48 * D), row = q / D, k = q % D;
        float w = 0.f; if (row < 32) w = ap->wr_e[(size_t)l * D * 32 + k * 32 + row]; else if (row < 36) w = ap->wr_g[(size_t)l * D * 4 + k * 4 + (row - 32)];
        w *= ap->norm_ffn[l * D + k];
        const unsigned hb = cvt_pk_bf16(w, 0.f) & 0xffffu; const float lo_ = w - __uint_as_float(hb << 16);
        WR[(size_t)(l * 2 + 0) * 48 * D + row * D + k] = (bf16_t)hb; WR[(size_t)(l * 2 + 1) * 48 * D + row * D + k] = (bf16_t)(cvt_pk_bf16(lo_, 0.f) & 0xffffu); }
    for (int i = blk * 512 + tid; i < NLAYER * 4 * 128 * 128; i += G * 512) { const int t = (i >> 7) & 127, s = i & 127; const float w = (s <= t) ? ap->w_sp[i] : 0.f; WSP[i] = (bf16_t)(cvt_pk_bf16(w, 0.f) & 0xffffu); }
    const float* x = ap->x;
    for (int m = gw; m < M; m += NGW) {
        const float* xr = x + (size_t)m * D + 8 * lane; float ss = 0.f; u32x4 pk[2];
#pragma unroll
        for (int j = 0; j < 2; ++j) { const f32x4 v0 = *(const f32x4*)(xr + 512 * j), v1 = *(const f32x4*)(xr + 512 * j + 4);
            pk[j].x = cvt_pk_bf16(v0.x, v0.y); pk[j].y = cvt_pk_bf16(v0.z, v0.w); pk[j].z = cvt_pk_bf16(v1.x, v1.y); pk[j].w = cvt_pk_bf16(v1.z, v1.w);
            const float a0 = bf_lo(pk[j].x), a1 = bf_hi(pk[j].x), a2 = bf_lo(pk[j].y), a3 = bf_hi(pk[j].y), a4 = bf_lo(pk[j].z), a5 = bf_hi(pk[j].z), a6 = bf_lo(pk[j].w), a7 = bf_hi(pk[j].w);
            ss += ((a0 * a0 + a1 * a1) + (a2 * a2 + a3 * a3)) + ((a4 * a4 + a5 * a5) + (a6 * a6 + a7 * a7)); }
        ss = wave_sum(ss);
        bf16_t* o = XSA + (size_t)m * D + 8 * lane;
#pragma unroll
        for (int j = 0; j < 2; ++j) *(u32x4*)(o + 512 * j) = pk[j];
        if (lane == 0) RSTD1[m] = 1.0f / sqrtf(ss * (1.0f / D) + RMS_EPS);
    }
}

struct ConvHook {
    const float* w_gate; const float* w_up; const float* w_down; const float* gain; bf16_t* W13l; bf16_t* WDl; int gw, ngw;
    __device__ __forceinline__ void operator()(int ui) const {
        if ((ui & 1) == 0 && ui < 6) { const int lane = (int)__builtin_amdgcn_mbcnt_hi(~0u, __builtin_amdgcn_mbcnt_lo(~0u, 0u)); const int it0 = (ui >> 1) * ngw + gw;
            conv_expert_weights(w_gate, w_up, w_down, gain, W13l, WDl, it0, 6144 * 4, lane, it0 + 1); }
    }
};
template <int LAYER> __device__ __forceinline__ void phase_in(LAS unsigned char* lds) {
    CArgs* ap = kargs(); unsigned char* ws = ap->ws;
    pg8::DenseOrder S; S.init(LAYER ? WSP_(bf16_t, WS_XSB) : WSP_(bf16_t, WS_XSA), WSP_(bf16_t, WS_WIN) + (size_t)LAYER * DIN * D, M, DIN, D, gridDim.x, blockIdx.x);
    unsigned char* ob = (unsigned char*)ap->out;
    LAS float* rsl = (LAS float*)(lds + TAB_OFF);
    { const int tid = otid(); const float* rstd = WSP_(float, WS_RSTD1); const float* ssq = (LAYER > 0 && gridDim.x == 256) ? WSP_(float, WS_SSQ) : nullptr;
      for (int i = 0; i < 8; ++i) { pg8::Unit u; if (!S.next(i, u)) break;
          if (tid < 256) { const int r = u.pm * 256 + tid; float v;
              if (ssq) { const f32x4* p = (const f32x4*)(ssq + (size_t)r * 16); const f32x4 a = p[0], b = p[1], c = p[2], d = p[3];
                  const float t = ((a[0] + a[1]) + (a[2] + a[3])) + ((b[0] + b[1]) + (b[2] + b[3])) + (((c[0] + c[1]) + (c[2] + c[3])) + ((d[0] + d[1]) + (d[2] + d[3])));
                  v = 1.0f / sqrtf(t * (1.0f / D) + RMS_EPS); }
              else v = rstd[r];
              rsl[i * 256 + tid] = v; } }
      __syncthreads(); }
    EpiIn E{WSP_(bf16_t, WS_QT), WSP_(bf16_t, WS_KT), WSP_(bf16_t, WS_VH), WSP_(bf16_t, WS_GH), (bf16_t*)(ob + OUT_U), (bf16_t*)(ob + OUT_V), WSP_(float, WS_EB), WSP_(float, WS_ER), WSP_(float, WS_EK),
            rsl, ap->lb_logits, LAYER};
    if (LAYER == 0 && gridDim.x == 256) {
        const int t_ = otid(), wave = __builtin_amdgcn_readfirstlane(t_ >> 6);
        ConvHook H{ap->w_gate, ap->w_up, ap->w_down, ap->norm_ffn, WSP_(bf16_t, WS_W13), WSP_(bf16_t, WS_WD), (int)blockIdx.x * 8 + wave, 2048};
        pg8::gemm_phase<EpiIn, pg8::DenseOrder, false, ConvHook>(lds, D, S, E, nullptr, H);
    } else pg8::gemm_phase<EpiIn, pg8::DenseOrder, false>(lds, D, S, E, nullptr);
}

template <int LAYER> __device__ __forceinline__ void phase_mixer_a(LAS unsigned char* lds, int rep) {
    CArgs* ap = kargs(); unsigned char* ws = ap->ws;
    const int sel = rep ? MK_MIXSEL : 15;
    const int G = gridDim.x, blk = blockIdx.x;
    unsigned char* ob = (unsigned char*)ap->out; bf16_t* YB = (bf16_t*)(ob + OUT_Y);
    if (sel & 1) { const float* gn = ap->hgrn_norm + LAYER * 128;
        for (int u = blk; u < 256; u += G) hgrn_pass1(lds, WSP_(bf16_t, WS_QT), WSP_(bf16_t, WS_KT), WSP_(bf16_t, WS_VH), WSP_(bf16_t, WS_GH), WSP_(float, WS_EB), WSP_(float, WS_ER), WSP_(float, WS_EK),
                                                      WSP_(bf16_t, WS_OL), WSP_(float, WS_SL), WSP_(float, WS_DL), YB, gn, u >> 4, (u >> 2) & 3, u & 3); }
    if ((sel & 4) && LAYER == 0 && G != 256) { const int t_ = otid(), wave = __builtin_amdgcn_readfirstlane(t_ >> 6), lane = t_ & 63;
        conv_expert_weights(ap->w_gate + (size_t)LAYER * NEXP * D * DEXP, ap->w_up + (size_t)LAYER * NEXP * D * DEXP, ap->w_down + (size_t)LAYER * NEXP * DEXP * D, ap->norm_ffn + LAYER * D,
                            WSP_(bf16_t, WS_W13) + (size_t)LAYER * NEXP * 512 * D, WSP_(bf16_t, WS_WD) + (size_t)LAYER * NEXP * D * DEXP, blk * 8 + wave, G * 8, lane); }
}
template <int LAYER> __device__ __forceinline__ void phase_mixer_b(LAS unsigned char* lds, int rep) {
    CArgs* ap = kargs(); unsigned char* ws = ap->ws;
    const int sel = rep ? MK_MIXSEL : 15;
    const int G = gridDim.x, blk = blockIdx.x;
    unsigned char* ob = (unsigned char*)ap->out; bf16_t* YB = (bf16_t*)(ob + OUT_Y);
    if (sel & 8) { const float* gn = ap->hgrn_norm + LAYER * 128;
        for (int j = blk; j < 192; j += G) { const int bh = j / 3, seg = 1 + j % 3;
            hgrn_pass2(lds, WSP_(bf16_t, WS_QT), WSP_(bf16_t, WS_GH), WSP_(float, WS_EB), WSP_(float, WS_ER), WSP_(bf16_t, WS_OL), WSP_(float, WS_SL), WSP_(float, WS_DL), YB, gn, bh >> 2, bh & 3, seg); } }
    if (sel & 2) {
        const bf16_t* wsp = WSP_(bf16_t, WS_WSP) + (size_t)LAYER * 4 * 128 * 128; const float* lng = ap->ln_g + LAYER * 512; const float* lnb = ap->ln_b + LAYER * 512; const float* bsp = ap->b_sp + LAYER * 512;
        int i0, i1, st;
        if (G == 256) { if (blk < 192) { i0 = 2 * blk; i1 = i0 + 2; } else { i0 = 384 + 10 * (blk - 192); i1 = i0 + 10; } st = 1; }
        else { i0 = blk; i1 = 1024; st = G; }
        __syncthreads();
        tmlp_units(lds, (const bf16_t*)(ob + OUT_U), (const bf16_t*)(ob + OUT_V), YB, wsp, lng, lnb, bsp, i0, i1, st);
    }
}

template <int LAYER> __device__ __forceinline__ void phase_out(LAS unsigned char* lds, int rep) {
    CArgs* ap = kargs(); unsigned char* ws = ap->ws;
    pg8::DenseOrder S; S.init(ap->out, WSP_(bf16_t, WS_WOUT) + (size_t)LAYER * D * D, M, D, D, gridDim.x, blockIdx.x);
    bf16_t* xs = LAYER ? WSP_(bf16_t, WS_XSB) : WSP_(bf16_t, WS_XSA);
    EpiOut E{xs, rep ? WSP_(bf16_t, WS_Z) : xs};
    pg8::gemm_phase<EpiOut, pg8::DenseOrder, false>(lds, D, S, E, nullptr);
}

constexpr int R_P = 0, R_HIST = 100352, R_BASE = R_HIST + 256, R_REC = R_BASE + 256, R_H2 = R_REC + 4096, R_B2 = R_H2 + 1024;
template <int LAYER> __device__ __forceinline__ void phase_router(LAS unsigned char* lds, int rep) {
    CArgs* ap = kargs(); unsigned char* ws = ap->ws;
    const int tid = otid(), lane = tid & 63, wave = __builtin_amdgcn_readfirstlane(tid >> 6), G = gridDim.x, blk = blockIdx.x;
    const bf16_t* XC = LAYER ? WSP_(bf16_t, WS_XSB) : WSP_(bf16_t, WS_XSA);
    unsigned* cnt = WSP_(unsigned, WS_CTL) + CW_CNT + LAYER * 64 * 64;
    int* LIST = WSP_(int, WS_LIST); float* RSV = WSP_(float, WS_RS); float* WTV = WSP_(float, WS_WT); int* TOKC = WSP_(int, WS_TOKC);
    const bf16_t* wrh = WSP_(bf16_t, WS_WR) + (size_t)(LAYER * 2) * 48 * D; const bf16_t* wrl = wrh + 48 * D;
    LAS float* P = (LAS float*)(lds + R_P); LAS unsigned* hist = (LAS unsigned*)(lds + R_HIST); LAS unsigned* basel = (LAS unsigned*)(lds + R_BASE); LAS unsigned* REC = (LAS unsigned*)(lds + R_REC);
    LAS unsigned* hist2 = (LAS unsigned*)(lds + R_H2); LAS unsigned* base2 = (LAS unsigned*)(lds + R_B2);
    unsigned* cnt2 = WSP_(unsigned, WS_CTL) + CW_CNT2 + LAYER * 256 * 64; int* CLIST = WSP_(int, WS_CLIST);
    if (blk == 0 && tid < 128) ((unsigned*)((unsigned char*)ap->out + OUT_HID + (size_t)ZROW * DEXP * 2))[tid] = 0u;
    const int fr = lane & 15, fq = lane >> 4;
    bf16x8 bh[3][4], bl[3][4];
#pragma unroll
    for (int nt = 0; nt < 3; ++nt)
#pragma unroll
        for (int ks = 0; ks < 4; ++ks) { const size_t o = (size_t)(nt * 16 + fr) * D + 128 * wave + ks * 32 + fq * 8; bh[nt][ks] = *(const bf16x8*)(wrh + o); bl[nt][ks] = *(const bf16x8*)(wrl + o); }
    for (int rp = blk; rp < M / 128; rp += G) {
        if (tid < 32) hist[tid] = 0u;
        if (tid < 256) hist2[tid] = 0u;
#pragma unroll 1
        for (int r = 0; r < 2; ++r) {
#pragma unroll 1
            for (int j = 0; j < 4; ++j) {
                const bf16_t* xrow = XC + (size_t)(rp * 128 + (4 * r + j) * 16 + fr) * D + 128 * wave + fq * 8;
                u32x4 aw[4];
#pragma unroll
                for (int ks = 0; ks < 4; ++ks) aw[ks] = *(const u32x4*)(xrow + ks * 32);
                f32x4 acc[3]; float ss = 0.f;
#pragma unroll
                for (int i = 0; i < 3; ++i) acc[i] = (f32x4){0.f, 0.f, 0.f, 0.f};
#pragma unroll
                for (int ks = 0; ks < 4; ++ks) {
                    { const float a0 = bf_lo(aw[ks].x), a1 = bf_hi(aw[ks].x), a2 = bf_lo(aw[ks].y), a3 = bf_hi(aw[ks].y), a4 = bf_lo(aw[ks].z), a5 = bf_hi(aw[ks].z), a6 = bf_lo(aw[ks].w), a7 = bf_hi(aw[ks].w);
                      ss += ((a0 * a0 + a1 * a1) + (a2 * a2 + a3 * a3)) + ((a4 * a4 + a5 * a5) + (a6 * a6 + a7 * a7)); }
                    const bf16x8 af = __builtin_bit_cast(bf16x8, aw[ks]);
#pragma unroll
                    for (int nt = 0; nt < 3; ++nt) { acc[nt] = __builtin_amdgcn_mfma_f32_16x16x32_bf16(af, bh[nt][ks], acc[nt], 0, 0, 0); acc[nt] = __builtin_amdgcn_mfma_f32_16x16x32_bf16(af, bl[nt][ks], acc[nt], 0, 0, 0); }
                }
                ss += __shfl_xor(ss, 16); ss += __shfl_xor(ss, 32);
                LAS float* pw = P + (wave * 4 + j) * 16 * 49;
#pragma unroll
                for (int nt = 0; nt < 3; ++nt)
#pragma unroll
                    for (int i = 0; i < 4; ++i) pw[(4 * fq + i) * 49 + nt * 16 + fr] = acc[nt][i];
                if (fq == 0) pw[fr * 49 + 48] = ss;
            }
            __syncthreads();
            if (wave < 4 && lane < 16) {
                float gl[4] = {0.f, 0.f, 0.f, 0.f}; float ss = 0.f;
                const LAS float* pr0 = P + (wave * 16 + lane) * 49;
#pragma unroll
                for (int w = 0; w < 8; ++w) { const LAS float* pr = pr0 + w * (4 * 16 * 49);
#pragma unroll
                    for (int c = 0; c < 4; ++c) gl[c] += pr[32 + c];
                    ss += pr[48]; }
                const float rstd = 1.0f / sqrtf(ss * (1.0f / D) + RMS_EPS);
                int gi = 0;
#pragma unroll
                for (int c = 0; c < 4; ++c) gl[c] *= rstd;
                float gm = gl[0];
#pragma unroll
                for (int c = 1; c < 4; ++c) if (gl[c] > gm) { gm = gl[c]; gi = c; }
                float den = 0.f;
#pragma unroll
                for (int c = 0; c < 4; ++c) den += fexp(gl[c] - gm);
                const float psel = 1.0f / den;
                float ev[8] = {0.f, 0.f, 0.f, 0.f, 0.f, 0.f, 0.f, 0.f};
#pragma unroll
                for (int w = 0; w < 8; ++w) { const LAS float* pr = pr0 + w * (4 * 16 * 49) + gi * 8;
#pragma unroll
                    for (int c = 0; c < 8; ++c) ev[c] += pr[c]; }
#pragma unroll
                for (int c = 0; c < 8; ++c) ev[c] *= rstd;
                int i1 = 0; float v1 = ev[0];
#pragma unroll
                for (int c = 1; c < 8; ++c) if (ev[c] > v1) { v1 = ev[c]; i1 = c; }
                int i2 = -1; float v2 = -3.0e38f;
#pragma unroll
                for (int c = 0; c < 8; ++c) if (c != i1 && ev[c] > v2) { v2 = ev[c]; i2 = c; }
                const float w1 = psel / (1.0f + fexp(v2 - v1)), w2 = psel - w1;
                const int e1 = gi * 8 + i1, e2 = gi * 8 + i2;
                const int elo = e1 < e2 ? e1 : e2, ehi = e1 < e2 ? e2 : e1; const float wlo = e1 < e2 ? w1 : w2, whi = e1 < e2 ? w2 : w1;
                const unsigned r1 = __hip_atomic_fetch_add(hist + elo, 1u, __ATOMIC_RELAXED, __HIP_MEMORY_SCOPE_WORKGROUP);
                const unsigned r2 = __hip_atomic_fetch_add(hist + ehi, 1u, __ATOMIC_RELAXED, __HIP_MEMORY_SCOPE_WORKGROUP);
                LAS unsigned* rec = REC + ((4 * r + wave) * 16 + lane) * 8;
                const unsigned r3 = __hip_atomic_fetch_add(hist2 + elo * 8 + (ehi & 7), 1u, __ATOMIC_RELAXED, __HIP_MEMORY_SCOPE_WORKGROUP);
                rec[0] = (unsigned)elo; rec[1] = r1; rec[2] = (unsigned)ehi; rec[3] = r2; rec[7] = r3; rec[4] = __float_as_uint(wlo); rec[5] = __float_as_uint(whi); rec[6] = __float_as_uint(rstd);
            }
            __syncthreads();
        }
        if (tid < 32) { const unsigned n = hist[tid]; basel[tid] = n ? __hip_atomic_fetch_add(cnt + tid * 64, n, __ATOMIC_RELAXED, __HIP_MEMORY_SCOPE_AGENT) : 0u; }
        if (tid < 256) { const unsigned n = hist2[tid]; base2[tid] = n ? __hip_atomic_fetch_add(cnt2 + tid * 64, n, __ATOMIC_RELAXED, __HIP_MEMORY_SCOPE_AGENT) : 0u; }
        __syncthreads();
        if (tid < 128) {
            const LAS unsigned* rec = REC + tid * 8; const int token = rp * 128 + tid;
            const unsigned c1 = rec[0], s1 = basel[c1] + rec[1], c2 = rec[2], s2 = basel[c2] + rec[3]; const float rstd = __uint_as_float(rec[6]);
            if (s1 < (unsigned)LISTCAP) { const size_t o = (size_t)c1 * LISTCAP + s1; LIST[o] = token; RSV[o] = rstd; WTV[o] = __uint_as_float(rec[4]); }
            if (s2 < (unsigned)LISTCAP) { const size_t o = (size_t)c2 * LISTCAP + s2; LIST[o] = token; RSV[o] = rstd; WTV[o] = __uint_as_float(rec[5]); }
            *(u32x4*)(TOKC + (size_t)token * 4) = (u32x4){c1, s1, c2, s2};
            { const unsigned cls = c1 * 8 + (c2 & 7), s3 = base2[cls] + rec[7]; if (s3 < (unsigned)CLCAP) CLIST[cls * CLCAP + s3] = token; }
        }
        __syncthreads();
    }
}

__device__ __forceinline__ void moe_tables(LAS int* pre, LAS int* cntl, const unsigned* cnt, int tid) {
    __syncthreads();
    if (tid < 32) { unsigned v = __hip_atomic_load(cnt + tid * 64, __ATOMIC_RELAXED, __HIP_MEMORY_SCOPE_AGENT); if (v > (unsigned)LISTCAP) v = LISTCAP; cntl[tid] = (int)v; }
    __syncthreads();
    if (tid == 0) { int a = 0; for (int c = 0; c < 32; ++c) { pre[c] = a; a += (cntl[c] + 255) >> 8; } pre[32] = a; }
    __syncthreads();
}
template <int LAYER, int WHICH> __device__ __forceinline__ void phase_moe(LAS unsigned char* lds, int rep) {
    CArgs* ap = kargs(); unsigned char* ws = ap->ws;
    const int tid = otid(), G = gridDim.x, blk = blockIdx.x;
    LAS int* tab = (LAS int*)(lds + TAB_OFF); LAS int* pre = (LAS int*)(lds + MOE_OFF); LAS int* cntl = pre + 80;
    const int* LIST = WSP_(int, WS_LIST);
    const bf16_t* XC = LAYER ? WSP_(bf16_t, WS_XSB) : WSP_(bf16_t, WS_XSA);
    bf16_t* HID = (bf16_t*)((unsigned char*)ap->out + OUT_HID);
    moe_tables(pre, cntl, WSP_(unsigned, WS_CTL) + CW_CNT + LAYER * 64 * 64, tid);
    if (WHICH == 0) {
        MoeOrder S{pre, cntl, (const char*)XC, (const char*)(WSP_(bf16_t, WS_W13) + (size_t)LAYER * NEXP * 512 * D), 0, 32, 2, G, blk, 0, (size_t)512 * D * 2, (size_t)256 * D * 2, true};
        for (int i = 0; i < 4; ++i) { pg8::Unit u; if (!S.next(i, u)) break; if (tid < 256) tab[i * 256 + tid] = tid < u.nvalid ? LIST[u.lbase + tid] : 0; }
        __syncthreads();
        EpiMoe1 E{HID, WSP_(float, WS_RS), WSP_(float, WS_WT)};
        pg8::gemm_phase<EpiMoe1, MoeOrder, true>(lds, D, S, E, tab);
        if (LAYER + 1 < NLAYER && rep == 0) {
            const int total = pre[32] * 2, rem = total % G, P = rem ? G - rem : G, rank = rem ? blk - rem : blk;
            if (rank >= 0) { const int t_ = otid(), wave = __builtin_amdgcn_readfirstlane(t_ >> 6), lane = t_ & 63; constexpr int NL = LAYER + 1;
                conv_expert_weights(ap->w_gate + (size_t)NL * NEXP * D * DEXP, ap->w_up + (size_t)NL * NEXP * D * DEXP, ap->w_down + (size_t)NL * NEXP * DEXP * D, ap->norm_ffn + NL * D,
                                    WSP_(bf16_t, WS_W13) + (size_t)NL * NEXP * 512 * D, WSP_(bf16_t, WS_WD) + (size_t)NL * NEXP * D * DEXP, rank * 8 + wave, P * 8, lane); }
        }
    } else {
        MoeOrder S{pre, cntl, (const char*)HID, (const char*)(WSP_(bf16_t, WS_WD) + (size_t)LAYER * NEXP * D * DEXP), 0, 32, 4, G, blk, (size_t)256 * DEXP * 2, (size_t)D * DEXP * 2, (size_t)256 * DEXP * 2, false};
        EpiMoe2 E{WSP_(bf16_t, WS_EO)};
        pg8::gemm_phase<EpiMoe2, MoeOrder, false>(lds, DEXP, S, E, tab);
    }
}

constexpr int PT_TAB = 131072, PT_TOK = PT_TAB + 16384, PT_MISC = PT_TOK + 2048;
struct EpiPair {
    const bf16_t* XC; bf16_t* XO; float* SSQ; const LAS int* tok;
    __device__ __forceinline__ void operator()(const f32x4 (&acc)[2][2][4][2], const pg8::Unit& u, int wr, int wc, int fr, int fq) const {
        const int lr0 = wr * 64 + fr, col0 = u.pn * 256 + wc * 32 + 8 * fq;
#pragma unroll
        for (int ai = 0; ai < 2; ++ai)
#pragma unroll
            for (int m = 0; m < 4; ++m) {
                const int lr = lr0 + ai * 128 + m * 16; const int token = tok[u.pm * 256 + lr]; const size_t off = (size_t)token * D + col0; float ss = 0.f;
#pragma unroll
                for (int bj = 0; bj < 2; ++bj) {
                    const u32x4 o = *(const u32x4*)(XC + off + bj * 128);
                    const f32x4 a0 = acc[ai][bj][m][0], a1 = acc[ai][bj][m][1];
                    u32x4 w; w.x = cvt_pk_bf16(bf_lo(o.x) + a0[0], bf_hi(o.x) + a0[1]); w.y = cvt_pk_bf16(bf_lo(o.y) + a0[2], bf_hi(o.y) + a0[3]);
                    w.z = cvt_pk_bf16(bf_lo(o.z) + a1[0], bf_hi(o.z) + a1[1]); w.w = cvt_pk_bf16(bf_lo(o.w) + a1[2], bf_hi(o.w) + a1[3]);
                    *(u32x4*)(XO + off + bj * 128) = w;
                    const float b0 = bf_lo(w.x), b1 = bf_hi(w.x), b2 = bf_lo(w.y), b3 = bf_hi(w.y), b4 = bf_lo(w.z), b5 = bf_hi(w.z), b6 = bf_lo(w.w), b7 = bf_hi(w.w);
                    ss += ((b0 * b0 + b1 * b1) + (b2 * b2 + b3 * b3)) + ((b4 * b4 + b5 * b5) + (b6 * b6 + b7 * b7));
                }
                ss += __shfl_xor(ss, 16); ss += __shfl_xor(ss, 32);
                if (fq == 0) SSQ[(size_t)token * 16 + u.pn * 4 + wc] = ss;
            }
    }
};
struct PairOrder {
    const LAS int* nb; const LAS int* el; const char* hid; const char* wd; int nun, sub;
    __device__ bool next(int i, pg8::Unit& u) const {
        int uu = 0, b = i;
        if (nun > 1 && b >= nb[0]) { b -= nb[0]; uu = 1; }
        if (uu >= nun || b >= nb[uu]) return false;
        u.pm = uu; u.pn = sub; u.nvalid = 256; u.lbase = 0; u.slot = uu * 8 + b; u.fin = (b == nb[uu] - 1);
        u.A = hid; u.B = wd + (size_t)el[uu * 8 + b] * ((size_t)D * DEXP * 2) + (size_t)sub * ((size_t)256 * DEXP * 2);
        return true;
    }
};
template <int LAYER> __device__ __forceinline__ void phase_pair(LAS unsigned char* lds) {
    CArgs* ap = kargs(); unsigned char* ws = ap->ws;
    const int tid = otid(), G = gridDim.x, blk = blockIdx.x;
    LAS int* tabA = (LAS int*)(lds + PT_TAB); LAS int* tokl = (LAS int*)(lds + PT_TOK); LAS int* misc = (LAS int*)(lds + PT_MISC);
    LAS int* pre = misc; LAS int* cntl = misc + 40; LAS int* cpre = misc + 72; LAS int* nbl = misc + 332; LAS int* ell = misc + 334; LAS unsigned* maskl = (LAS unsigned*)(misc + 350);
    const bf16_t* XC = LAYER ? WSP_(bf16_t, WS_XSB) : WSP_(bf16_t, WS_XSA); bf16_t* XO = LAYER ? WSP_(bf16_t, WS_XSA) : WSP_(bf16_t, WS_XSB);
    const bf16_t* HID = (const bf16_t*)((unsigned char*)ap->out + OUT_HID);
    const int* CLIST = WSP_(int, WS_CLIST); const int* TOKC = WSP_(int, WS_TOKC);
    moe_tables(pre, cntl, WSP_(unsigned, WS_CTL) + CW_CNT + LAYER * 64 * 64, tid);
    if (tid < 256) { unsigned v = __hip_atomic_load(WSP_(unsigned, WS_CTL) + CW_CNT2 + (LAYER * 256 + tid) * 64, __ATOMIC_RELAXED, __HIP_MEMORY_SCOPE_AGENT); if (v > (unsigned)CLCAP) v = CLCAP; cpre[tid + 1] = (int)v; }
    if (tid == 0) { cpre[0] = 0; maskl[0] = 0u; maskl[1] = 0u; }
    __syncthreads();
    if (tid == 0) { int a = 0; for (int c = 1; c <= 256; ++c) { a += cpre[c]; cpre[c] = a; } }
    __syncthreads();
    LAS int* tnb = misc + 352; LAS int* ord = misc + 480;
    if (tid < 128) { const int p0 = 256 * tid, p1 = p0 + 256; int lo = 0, hi = 256;
        while (hi - lo > 1) { const int mid = (lo + hi) >> 1; if (cpre[mid] <= p0) lo = mid; else hi = mid; }
        unsigned mk = 0u; for (int c = lo; c < 256 && cpre[c] < p1; ++c) if (cpre[c + 1] > cpre[c] && cpre[c + 1] > p0) { const int e0 = c >> 3, e1 = (e0 & ~7) | (c & 7); mk |= (1u << e0) | (1u << e1); }
        int n = __builtin_popcount(mk); tnb[tid] = n > 8 ? 8 : n; }
    __syncthreads();
    if (tid < 128) { const int mine = tnb[tid]; int rank = 0; for (int t = 0; t < 128; ++t) { const int o = tnb[t]; rank += (o > mine || (o == mine && t < tid)) ? 1 : 0; } ord[rank] = tid; }
    __syncthreads();
    const int nun = 2, sub = blk & 3; const int utile[2] = {ord[blk >> 2], ord[127 - (blk >> 2)]};
    int elo[2] = {0, 0}, ehi[2] = {0, 0}, rlo[2] = {0, 0}, rhi[2] = {0, 0};
#pragma unroll
    for (int uu = 0; uu < 2; ++uu) {
        if (uu < nun && tid < 256) {
            const int t = utile[uu], p = 256 * t + tid;
            int lo = 0, hi = 256;
            while (hi - lo > 1) { const int mid = (lo + hi) >> 1; if (cpre[mid] <= p) lo = mid; else hi = mid; }
            int token = 0; if (p < cpre[256]) token = CLIST[lo * CLCAP + (p - cpre[lo])];
            const u32x4 tc = *(const u32x4*)(TOKC + (size_t)token * 4);
            elo[uu] = (int)tc.x; ehi[uu] = (int)tc.z; rlo[uu] = pre[tc.x] * 256 + (int)tc.y; rhi[uu] = pre[tc.z] * 256 + (int)tc.w;
            tokl[uu * 256 + tid] = token;
            __hip_atomic_fetch_or(maskl + uu, (1u << elo[uu]) | (1u << ehi[uu]), __ATOMIC_RELAXED, __HIP_MEMORY_SCOPE_WORKGROUP);
        }
    }
    __syncthreads();
    if (tid < 2) { unsigned mk = maskl[tid]; int n = 0; while (mk && n < 8) { const int e = __builtin_ctz(mk); mk &= mk - 1; ell[tid * 8 + n] = e; ++n; } nbl[tid] = n; }
    __syncthreads();
#pragma unroll
    for (int uu = 0; uu < 2; ++uu) {
        if (uu < nun && tid < 256) { const int n = nbl[uu];
            for (int b = 0; b < n; ++b) { const int e = ell[uu * 8 + b]; tabA[(uu * 8 + b) * 256 + tid] = (elo[uu] == e) ? rlo[uu] : (ehi[uu] == e) ? rhi[uu] : ZROW; } }
    }
    __syncthreads();
    PairOrder S{nbl, ell, (const char*)HID, (const char*)(WSP_(bf16_t, WS_WD) + (size_t)LAYER * NEXP * D * DEXP), nun, sub};
    EpiPair E{XC, XO, WSP_(float, WS_SSQ), tokl};
    pg8::gemm_phase<EpiPair, PairOrder, true>(lds, DEXP, S, E, tabA);
}

template <int LAYER> __device__ __forceinline__ void phase_combine(LAS unsigned char* lds) {
    CArgs* ap = kargs(); unsigned char* ws = ap->ws;
    const int tid = otid(), lane = tid & 63, wave = __builtin_amdgcn_readfirstlane(tid >> 6), G = gridDim.x, blk = blockIdx.x;
    const int gw = blk * 8 + wave, NGW = G * 8;
    LAS int* pre = (LAS int*)(lds + MOE_OFF); LAS int* cntl = pre + 80;
    moe_tables(pre, cntl, WSP_(unsigned, WS_CTL) + CW_CNT + LAYER * 64 * 64, tid);
    const bf16_t* XC = LAYER ? WSP_(bf16_t, WS_XSB) : WSP_(bf16_t, WS_XSA); bf16_t* XO = LAYER ? WSP_(bf16_t, WS_XSA) : WSP_(bf16_t, WS_XSB);
    const bf16_t* EO = WSP_(bf16_t, WS_EO); const int* TOKC = WSP_(int, WS_TOKC); float* RSTD1 = WSP_(float, WS_RSTD1);
    const float* gf = ap->norm_final; float* out = ap->out;
    const unsigned poison = (__hip_atomic_load(WSP_(unsigned, WS_CTL) + CW_BAR + XB_TMO, __ATOMIC_RELAXED, __HIP_MEMORY_SCOPE_AGENT) != 0u);
    for (int m = gw; m < M; m += NGW) {
        const u32x4 tc = *(const u32x4*)(TOKC + (size_t)m * 4);
        const size_t ga = (size_t)(pre[tc.x] * 256 + (int)tc.y), gb = (size_t)(pre[tc.z] * 256 + (int)tc.w);
        const bf16_t* xr = XC + (size_t)m * D + 8 * lane; const bf16_t* ea = EO + ga * D + 8 * lane; const bf16_t* eb = EO + gb * D + 8 * lane;
        float v[16]; float ss = 0.f;
#pragma unroll
        for (int j = 0; j < 2; ++j) { const u32x4 x = *(const u32x4*)(xr + 512 * j), a = *(const u32x4*)(ea + 512 * j), b = *(const u32x4*)(eb + 512 * j);
            v[8 * j] = bf_lo(x.x) + bf_lo(a.x) + bf_lo(b.x); v[8 * j + 1] = bf_hi(x.x) + bf_hi(a.x) + bf_hi(b.x); v[8 * j + 2] = bf_lo(x.y) + bf_lo(a.y) + bf_lo(b.y); v[8 * j + 3] = bf_hi(x.y) + bf_hi(a.y) + bf_hi(b.y);
            v[8 * j + 4] = bf_lo(x.z) + bf_lo(a.z) + bf_lo(b.z); v[8 * j + 5] = bf_hi(x.z) + bf_hi(a.z) + bf_hi(b.z); v[8 * j + 6] = bf_lo(x.w) + bf_lo(a.w) + bf_lo(b.w); v[8 * j + 7] = bf_hi(x.w) + bf_hi(a.w) + bf_hi(b.w); }
        if (LAYER + 1 < NLAYER) {
            u32x4 pk[2];
#pragma unroll
            for (int j = 0; j < 2; ++j) { pk[j].x = cvt_pk_bf16(v[8 * j], v[8 * j + 1]); pk[j].y = cvt_pk_bf16(v[8 * j + 2], v[8 * j + 3]); pk[j].z = cvt_pk_bf16(v[8 * j + 4], v[8 * j + 5]); pk[j].w = cvt_pk_bf16(v[8 * j + 6], v[8 * j + 7]);
                const float a0 = bf_lo(pk[j].x), a1 = bf_hi(pk[j].x), a2 = bf_lo(pk[j].y), a3 = bf_hi(pk[j].y), a4 = bf_lo(pk[j].z), a5 = bf_hi(pk[j].z), a6 = bf_lo(pk[j].w), a7 = bf_hi(pk[j].w);
                ss += ((a0 * a0 + a1 * a1) + (a2 * a2 + a3 * a3)) + ((a4 * a4 + a5 * a5) + (a6 * a6 + a7 * a7)); }
            ss = wave_sum(ss);
            bf16_t* o = XO + (size_t)m * D + 8 * lane;
#pragma unroll
            for (int j = 0; j < 2; ++j) *(u32x4*)(o + 512 * j) = pk[j];
            if (lane == 0) RSTD1[m] = 1.0f / sqrtf(ss * (1.0f / D) + RMS_EPS);
        } else {
#pragma unroll
            for (int i = 0; i < 16; ++i) ss += v[i] * v[i];
            ss = wave_sum(ss);
            float rstd = 1.0f / sqrtf(ss * (1.0f / D) + RMS_EPS);
            if (poison) rstd = __builtin_nanf("");
            float* o = out + (size_t)m * D + 8 * lane;
#pragma unroll
            for (int j = 0; j < 2; ++j) { const f32x4 g0 = *(const f32x4*)(gf + 512 * j + 8 * lane), g1 = *(const f32x4*)(gf + 512 * j + 8 * lane + 4);
                *(f32x4*)(o + 512 * j) = (f32x4){v[8 * j] * rstd * g0[0], v[8 * j + 1] * rstd * g0[1], v[8 * j + 2] * rstd * g0[2], v[8 * j + 3] * rstd * g0[3]};
                *(f32x4*)(o + 512 * j + 4) = (f32x4){v[8 * j + 4] * rstd * g1[0], v[8 * j + 5] * rstd * g1[1], v[8 * j + 6] * rstd * g1[2], v[8 * j + 7] * rstd * g1[3]}; }
        }
    }
}

__device__ __forceinline__ void phase_rownorm(LAS unsigned char* lds) {
    CArgs* ap = kargs(); unsigned char* ws = ap->ws;
    const int tid = otid(), lane = tid & 63, wave = __builtin_amdgcn_readfirstlane(tid >> 6), G = gridDim.x, blk = blockIdx.x;
    const int gw = blk * 8 + wave, NGW = G * 8;
    const bf16_t* XO = WSP_(bf16_t, WS_XSB); float* RSTD1 = WSP_(float, WS_RSTD1);
    for (int m = gw; m < M; m += NGW) {
        const u32x4* xr = (const u32x4*)(XO + (size_t)m * D) + lane; float ss = 0.f;
#pragma unroll
        for (int j = 0; j < 2; ++j) { const u32x4 w = xr[64 * j];
            const float a0 = bf_lo(w.x), a1 = bf_hi(w.x), a2 = bf_lo(w.y), a3 = bf_hi(w.y), a4 = bf_lo(w.z), a5 = bf_hi(w.z), a6 = bf_lo(w.w), a7 = bf_hi(w.w);
            ss += ((a0 * a0 + a1 * a1) + (a2 * a2 + a3 * a3)) + ((a4 * a4 + a5 * a5) + (a6 * a6 + a7 * a7)); }
        ss = wave_sum(ss);
        if (lane == 0) RSTD1[m] = 1.0f / sqrtf(ss * (1.0f / D) + RMS_EPS);
    }
}

__device__ __forceinline__ void phase_final(LAS unsigned char* lds) {
    CArgs* ap = kargs(); unsigned char* ws = ap->ws;
    const int tid = otid(), lane = tid & 63, wave = __builtin_amdgcn_readfirstlane(tid >> 6), G = gridDim.x, blk = blockIdx.x;
    const int gw = blk * 8 + wave, NGW = G * 8;
    const bf16_t* XF = WSP_(bf16_t, WS_XSA);
    const float* gf = ap->norm_final; float* out = ap->out;
    const unsigned poison = (__hip_atomic_load(WSP_(unsigned, WS_CTL) + CW_BAR + XB_TMO, __ATOMIC_RELAXED, __HIP_MEMORY_SCOPE_AGENT) != 0u);
    for (int m = gw; m < M; m += NGW) {
        const u32x4* xr = (const u32x4*)(XF + (size_t)m * D) + lane; float v[16]; float ss = 0.f;
#pragma unroll
        for (int j = 0; j < 2; ++j) { const u32x4 w = xr[64 * j];
            v[8 * j] = bf_lo(w.x); v[8 * j + 1] = bf_hi(w.x); v[8 * j + 2] = bf_lo(w.y); v[8 * j + 3] = bf_hi(w.y); v[8 * j + 4] = bf_lo(w.z); v[8 * j + 5] = bf_hi(w.z); v[8 * j + 6] = bf_lo(w.w); v[8 * j + 7] = bf_hi(w.w); }
#pragma unroll
        for (int i = 0; i < 16; ++i) ss += v[i] * v[i];
        ss = wave_sum(ss);
        float rstd = 1.0f / sqrtf(ss * (1.0f / D) + RMS_EPS);
        if (poison) rstd = __builtin_nanf("");
        f32x4* o = (f32x4*)(out + (size_t)m * D);
#pragma unroll
        for (int j = 0; j < 2; ++j) { const int c = (64 * j + lane) * 8; const f32x4 g0 = *(const f32x4*)(gf + c), g1 = *(const f32x4*)(gf + c + 4);
            o[(c >> 2)] = (f32x4){v[8 * j] * rstd * g0[0], v[8 * j + 1] * rstd * g0[1], v[8 * j + 2] * rstd * g0[2], v[8 * j + 3] * rstd * g0[3]};
            o[(c >> 2) + 1] = (f32x4){v[8 * j + 4] * rstd * g1[0], v[8 * j + 5] * rstd * g1[1], v[8 * j + 6] * rstd * g1[2], v[8 * j + 7] * rstd * g1[3]}; }
    }
}

#define IN(k) (lo <= (k) && (k) < hi)
#define SEAM(k) do { if (IN(k) && IN((k) + 1)) grid_seam(lds); } while (0)
#define REPS(bit) (((MK_REPEAT) >> (bit)) & 1)
template <int LAYER> __device__ __forceinline__ void layer_program(LAS unsigned char* lds, const int lo, const int hi) {
    constexpr int pb = 8 * LAYER;
    if (IN(pb + 1)) {
#pragma unroll 1
        for (int rep = 0; rep <= REPS(1); ++rep) { if (rep) grid_seam(lds); phase_in<LAYER>(lds); } }
    SEAM(pb + 1);
    if (IN(pb + 2)) {
#pragma unroll 1
        for (int rep = 0; rep <= REPS(2); ++rep) { if (rep) grid_seam(lds); phase_mixer_a<LAYER>(lds, rep); grid_seam(lds); phase_mixer_b<LAYER>(lds, rep); } }
    SEAM(pb + 2);
    if (IN(pb + 3)) {
#pragma unroll 1
        for (int rep = 0; rep <= REPS(3); ++rep) { if (rep) grid_seam(lds); phase_out<LAYER>(lds, rep); } }
    SEAM(pb + 3);
    if (IN(pb + 4)) {
#pragma unroll 1
        for (int rep = 0; rep <= REPS(4); ++rep) { if (rep) grid_seam(lds); phase_router<LAYER>(lds, rep); } }
    SEAM(pb + 4);
    if (IN(pb + 5)) {
#pragma unroll 1
        for (int rep = 0; rep <= REPS(5); ++rep) { if (rep) grid_seam(lds); phase_moe<LAYER, 0>(lds, rep); } }
    SEAM(pb + 5);
    const bool pair = (LAYER + 1 < NLAYER) && gridDim.x == 256;
    if (IN(pb + 6)) {
        if (pair) {
#pragma unroll 1
            for (int rep = 0; rep <= REPS(6); ++rep) { if (rep) grid_seam(lds); phase_pair<LAYER>(lds); } }
        else {
#pragma unroll 1
        for (int rep = 0; rep <= REPS(6); ++rep) { if (rep) grid_seam(lds); phase_moe<LAYER, 1>(lds, rep); } } }
    SEAM(pb + 6);
    if (!pair) {
    if (IN(pb + 7)) {
#pragma unroll 1
        for (int rep = 0; rep <= REPS(7); ++rep) { if (rep) grid_seam(lds); phase_combine<LAYER>(lds); } }
    if (LAYER + 1 < NLAYER) { if (IN(pb + 7) && IN(pb + 9)) grid_seam(lds); }
    }
}

__global__ void __launch_bounds__(512, 2) fwd_kernel(Args args) {
    extern __shared__ __attribute__((aligned(16))) unsigned char lds_raw[];
    LAS unsigned char* lds = (LAS unsigned char*)lds_raw;
    volatile LAS unsigned* MISC = (volatile LAS unsigned*)(lds + MISC_OFF);
    if (threadIdx.x < 64) MISC[threadIdx.x] = 0u;
    __syncthreads();
    const int lo = kargs()->ph_lo, hi = kargs()->ph_hi;
    if (!MK_PER_PHASE) (void)xcd_barrier_post((unsigned*)(kargs()->ws + WS_CTL) + CW_BAR, MISC + 8);
    if (IN(0)) {
#pragma unroll 1
        for (int rep = 0; rep <= REPS(0); ++rep) { if (rep) grid_seam(lds); phase_prologue(lds); } }
    SEAM(0);
#pragma unroll 1
    for (int i = 0; i < MK_XSEAM; ++i) grid_seam(lds);
    layer_program<0>(lds, lo, hi);
    layer_program<1>(lds, lo, hi);
}
#undef IN
#undef SEAM

extern "C" void kernel_launch(void* const* d_in, const int* in_sizes, int n_in, void* d_out, int out_size, void* d_ws, size_t ws_size, hipStream_t stream) {
    static int grid = 0;
    if (grid == 0) {
        if (n_in != 17 || in_sizes[0] != M * D || out_size != M * D || ws_size < WS_END) { fprintf(stderr, "kernel_launch: unexpected shapes (n_in %d, in0 %d, out %d, ws %zu; need ws >= %zu); nothing launched\n", n_in, n_in > 0 ? in_sizes[0] : -1, out_size, ws_size, (size_t)WS_END); grid = -1; return; }
        int dev = 0, cus = 0, per_cu = 0;
        if (hipGetDevice(&dev) != hipSuccess || hipDeviceGetAttribute(&cus, hipDeviceAttributeMultiprocessorCount, dev) != hipSuccess) { grid = -1; return; }
        if (hipFuncSetAttribute((const void*)fwd_kernel, hipFuncAttributeMaxDynamicSharedMemorySize, LDS_BYTES) != hipSuccess) { fprintf(stderr, "kernel_launch: hipFuncSetAttribute failed\n"); grid = -1; return; }
        if (hipOccupancyMaxActiveBlocksPerMultiprocessor(&per_cu, (const void*)fwd_kernel, 512, LDS_BYTES) != hipSuccess || per_cu < 1) { fprintf(stderr, "kernel_launch: occupancy query says %d blocks per CU\n", per_cu); }
        (void)hipGetLastError();
        grid = cus;
    }
    if (grid < 0) return;
    if (hipMemsetAsync((char*)d_ws + WS_CTL, 0, CTL_ZERO_BYTES, stream) != hipSuccess) return;
    Args a{};
    a.x = (const float*)d_in[0]; a.lb_logits = (const float*)d_in[1]; a.norm_mix = (const float*)d_in[2]; a.w_in = (const float*)d_in[3]; a.hgrn_norm = (const float*)d_in[4];
    a.ln_g = (const float*)d_in[5]; a.ln_b = (const float*)d_in[6]; a.w_sp = (const float*)d_in[7]; a.b_sp = (const float*)d_in[8]; a.w_out = (const float*)d_in[9];
    a.norm_ffn = (const float*)d_in[10]; a.wr_g = (const float*)d_in[11]; a.wr_e = (const float*)d_in[12]; a.w_gate = (const float*)d_in[13]; a.w_up = (const float*)d_in[14];
    a.w_down = (const float*)d_in[15]; a.norm_final = (const float*)d_in[16]; a.out = (float*)d_out; a.ws = (unsigned char*)d_ws;
#if MK_PER_PHASE
    for (int p = 0; p < NPHASE; ++p) { if (p == 16) continue; a.ph_lo = p; a.ph_hi = p + 1; hipLaunchKernelGGL(fwd_kernel, dim3(grid), dim3(512), LDS_BYTES, stream, a); }
#else
    a.ph_lo = 0; a.ph_hi = NPHASE;
    hipLaunchKernelGGL(fwd_kernel, dim3(grid), dim3(512), LDS_BYTES, stream, a);
#endif
}
```
